# Optimizing an MI355X kernel written in HIP

```python
import jax, jax.numpy as jnp
from jax import lax
import numpy as np

D_MODEL = 1024
BATCH = 4
SEQ = 4096
DEPTH = 4

M_HEADS = 4
M_DQK = 128
M_DV = 256
M_QK = M_HEADS * M_DQK
M_V = M_HEADS * M_DV
M_CHUNK = 128
CONV_W = 4
G_GROUPS = 4
G_WIDTH = 1024
G_DG = G_WIDTH // G_GROUPS
G_CHUNK = 128
D_FF = 2816
EPS = 1e-6
W_IN_COLS = 2 * M_QK + M_V + 2 * M_HEADS + M_V + 2 * G_WIDTH + 2 * D_MODEL

kernel_name = "hybrid_mlstm_gmlp_macaron_sandwich"


def _split_points():
    sizes = (M_QK, M_QK, M_V, M_HEADS, M_HEADS, M_V, G_WIDTH, G_WIDTH, D_MODEL, D_MODEL)
    return [int(s) for s in np.cumsum(np.array(sizes))[:-1]]


def rmsnorm(x, g):
    xf = x.astype(jnp.float32)
    y = xf * lax.rsqrt(jnp.mean(xf * xf, axis=-1, keepdims=True) + EPS)
    return (y * g.astype(jnp.float32)).astype(x.dtype)


def layernorm(x, g, b=None):
    xf = x.astype(jnp.float32)
    mu = jnp.mean(xf, axis=-1, keepdims=True)
    var = jnp.mean(jnp.square(xf - mu), axis=-1, keepdims=True)
    y = (xf - mu) * lax.rsqrt(var + EPS) * g.astype(jnp.float32)
    if b is not None:
        y = y + b.astype(jnp.float32)
    return y.astype(x.dtype)


def swiglu(x, w_in, w_out):
    a, g = jnp.split(x @ w_in, 2, axis=-1)
    return (jax.nn.silu(a) * g) @ w_out


def causal_dwconv(x, w, b):
    S = x.shape[1]
    xp = jnp.pad(x, ((0, 0), (CONV_W - 1, 0), (0, 0)))
    y = b
    for j in range(CONV_W):
        y = y + w[j] * xp[:, j:j + S]
    return y


def mlstm_chunkwise(q, k, v, i_pre, f_pre):
    B, S, H, _ = q.shape
    L = M_CHUNK
    nc = S // L
    f32 = jnp.float32
    q = q.astype(f32) * (M_DQK ** -0.5)
    k = k.astype(f32)
    v = v.astype(f32)
    log_i = i_pre.astype(f32)
    log_f = jax.nn.log_sigmoid(f_pre.astype(f32))

    def heads_chunks(a):
        return a.reshape(B, nc, L, H, a.shape[-1]).transpose(1, 0, 3, 2, 4)

    def gate_chunks(a):
        return a.reshape(B, nc, L, H).transpose(1, 0, 3, 2)

    qc, kc, vc = heads_chunks(q), heads_chunks(k), heads_chunks(v)
    ic = gate_chunks(log_i)
    bc = jnp.cumsum(gate_chunks(log_f), axis=-1)
    causal = jnp.tril(jnp.ones((L, L), dtype=bool))

    def step(carry, xs):
        C, n, m = carry
        qx, kx, vx, ix, bx = xs
        D = bx[..., :, None] - bx[..., None, :] + ix[..., None, :]
        D = jnp.where(causal, D, -jnp.inf)
        inter = bx + m[..., None]
        m_t = jnp.maximum(inter, jnp.max(D, axis=-1))
        W = jnp.exp(D - m_t[..., None]) * jnp.einsum('bhtd,bhsd->bhts', qx, kx)
        s_inter = jnp.exp(inter - m_t)
        num = (jnp.einsum('bhts,bhsv->bhtv', W, vx)
               + s_inter[..., None] * jnp.einsum('bhvd,bhtd->bhtv', C, qx))
        den = jnp.sum(W, axis=-1) + s_inter * jnp.einsum('bhd,bhtd->bht', n, qx)
        h = num / jnp.maximum(jnp.abs(den), jnp.exp(-m_t))[..., None]
        bL = bx[..., -1]
        g = bL[..., None] - bx + ix
        m_new = jnp.maximum(bL + m, jnp.max(g, axis=-1))
        w_s = jnp.exp(g - m_new[..., None])
        decay = jnp.exp(bL + m - m_new)
        C_new = decay[..., None, None] * C + jnp.einsum('bhs,bhsv,bhsd->bhvd', w_s, vx, kx)
        n_new = decay[..., None] * n + jnp.einsum('bhs,bhsd->bhd', w_s, kx)
        return (C_new, n_new, m_new), h

    init = (jnp.zeros((B, H, M_DV, M_DQK), f32),
            jnp.zeros((B, H, M_DQK), f32),
            jnp.zeros((B, H), f32))
    _, h = lax.scan(step, init, (qc, kc, vc, ic, bc))
    return h.transpose(1, 0, 3, 2, 4).reshape(B, S, H, M_DV)


def chunked_spatial_gating(u, v, g_norm_g, g_norm_b, w_s, b_s):
    B, S, _ = v.shape
    L = G_CHUNK
    nc = S // L
    v = layernorm(v, g_norm_g, g_norm_b)
    vc = v.reshape(B, nc, L, G_GROUPS, G_DG)
    ws = jnp.where(jnp.tril(jnp.ones((L, L), dtype=bool)), w_s, 0.0)
    s = jnp.einsum('gts,bcsgd->bctgd', ws, vc) + b_s.T[None, None, :, :, None]
    return u * s.reshape(B, S, G_WIDTH)


def token_mixer(h, w_in, conv_w, conv_b, i_bias, f_bias, m_norm_g,
                g_norm_g, g_norm_b, w_s, b_s, p_a, p_b, w_out):
    B, S, _ = h.shape
    z = h @ w_in
    q_r, k_r, v_m, i_pre, f_pre, o_pre, u_g, v_g, gate_a, gate_b = jnp.split(
        z, _split_points(), axis=-1)
    qk = jax.nn.silu(causal_dwconv(jnp.concatenate([q_r, k_r], axis=-1), conv_w, conv_b))
    q, k = jnp.split(qk, 2, axis=-1)
    hm = mlstm_chunkwise(q.reshape(B, S, M_HEADS, M_DQK),
                         k.reshape(B, S, M_HEADS, M_DQK),
                         v_m.reshape(B, S, M_HEADS, M_DV),
                         i_pre + i_bias, f_pre + f_bias).astype(h.dtype)
    hm = layernorm(hm, m_norm_g.reshape(M_HEADS, M_DV)).reshape(B, S, M_V)
    y_a = (jax.nn.sigmoid(o_pre) * hm) @ p_a
    hg = chunked_spatial_gating(jax.nn.gelu(u_g), jax.nn.gelu(v_g),
                                g_norm_g, g_norm_b, w_s, b_s)
    y_b = hg @ p_b
    merged = jax.nn.sigmoid(gate_a) * y_a + jax.nn.sigmoid(gate_b) * y_b
    return merged @ w_out


def setup_inputs(seed: int = 0) -> dict:
    key = jax.random.key(seed)
    ks = jax.random.split(key, 24)
    f32 = jnp.float32

    def nrm(k, shape, fan_in, scale=1.0):
        return (jax.random.normal(k, shape, f32) * (scale * fan_in ** -0.5)).astype(f32)

    x = jax.random.normal(ks[0], (BATCH, SEQ, D_MODEL), f32)
    norm_gains = 1.0 + 0.05 * jax.random.normal(ks[1], (DEPTH, 6, D_MODEL), f32)
    ffn1_w_in = nrm(ks[2], (DEPTH, D_MODEL, 2 * D_FF), D_MODEL)
    ffn1_w_out = nrm(ks[3], (DEPTH, D_FF, D_MODEL), D_FF)
    w_in = nrm(ks[4], (DEPTH, D_MODEL, W_IN_COLS), D_MODEL)
    conv_w = nrm(ks[5], (DEPTH, CONV_W, 2 * M_QK), CONV_W)
    conv_b = 0.02 * jax.random.normal(ks[6], (DEPTH, 2 * M_QK), f32)
    i_bias = 0.1 * jax.random.normal(ks[7], (DEPTH, M_HEADS), f32)
    f_bias = (jnp.linspace(3.0, 6.0, M_HEADS, dtype=f32)[None, :]
              + 0.1 * jax.random.normal(ks[8], (DEPTH, M_HEADS), f32))
    m_norm_g = 1.0 + 0.05 * jax.random.normal(ks[9], (DEPTH, M_V), f32)
    g_norm_g = 1.0 + 0.05 * jax.random.normal(ks[10], (DEPTH, G_WIDTH), f32)
    g_norm_b = 0.02 * jax.random.normal(ks[11], (DEPTH, G_WIDTH), f32)
    w_s = nrm(ks[12], (DEPTH, G_GROUPS, G_CHUNK, G_CHUNK), G_CHUNK, 0.5)
    b_s = 1.0 + 0.02 * jax.random.normal(ks[13], (DEPTH, G_GROUPS, G_CHUNK), f32)
    p_a = nrm(ks[14], (DEPTH, M_V, D_MODEL), M_V)
    p_b = nrm(ks[15], (DEPTH, G_WIDTH, D_MODEL), G_WIDTH)
    w_out = nrm(ks[16], (DEPTH, D_MODEL, D_MODEL), D_MODEL)
    ffn2_w_in = nrm(ks[17], (DEPTH, D_MODEL, 2 * D_FF), D_MODEL)
    ffn2_w_out = nrm(ks[18], (DEPTH, D_FF, D_MODEL), D_FF)
    return {"x": x, "norm_gains": norm_gains, "ffn1_w_in": ffn1_w_in, "ffn1_w_out": ffn1_w_out,
            "w_in": w_in, "conv_w": conv_w, "conv_b": conv_b, "i_bias": i_bias, "f_bias": f_bias,
            "m_norm_g": m_norm_g, "g_norm_g": g_norm_g, "g_norm_b": g_norm_b, "w_s": w_s,
            "b_s": b_s, "p_a": p_a, "p_b": p_b, "w_out": w_out,
            "ffn2_w_in": ffn2_w_in, "ffn2_w_out": ffn2_w_out}


def reference(x, norm_gains, ffn1_w_in, ffn1_w_out, w_in, conv_w, conv_b, i_bias, f_bias,
              m_norm_g, g_norm_g, g_norm_b, w_s, b_s, p_a, p_b, w_out,
              ffn2_w_in, ffn2_w_out):
    for l in range(DEPTH):
        g = norm_gains[l]
        x = x + 0.5 * rmsnorm(swiglu(rmsnorm(x, g[0]), ffn1_w_in[l], ffn1_w_out[l]), g[1])
        mix = token_mixer(rmsnorm(x, g[2]), w_in[l], conv_w[l], conv_b[l], i_bias[l], f_bias[l],
                          m_norm_g[l], g_norm_g[l], g_norm_b[l], w_s[l], b_s[l],
                          p_a[l], p_b[l], w_out[l])
        x = x + rmsnorm(mix, g[3])
        x = x + 0.5 * rmsnorm(swiglu(rmsnorm(x, g[4]), ffn2_w_in[l], ffn2_w_out[l]), g[5])
    return x
```

```cpp
#include <hip/hip_runtime.h>
#include <hip/hip_cooperative_groups.h>
#include <cstdio>
namespace cg = cooperative_groups;

#define LAS __attribute__((address_space(3)))
typedef unsigned short bf16_t;
typedef short bf16x8 __attribute__((ext_vector_type(8)));
typedef float f32x4 __attribute__((ext_vector_type(4)));
typedef float f32x2 __attribute__((ext_vector_type(2)));
typedef unsigned u32x4 __attribute__((ext_vector_type(4)));
typedef unsigned u32x2 __attribute__((ext_vector_type(2)));

constexpr int DM = 1024, NTOK = 16384, SEQ = 4096, DEPTH = 4;
constexpr int DFF = 2816, WIN_COLS = 7176;
constexpr int ZN = 5120;
constexpr int ZTR = 2048;
constexpr int HC = 2048;
constexpr int DCJ = 257 * 128;
constexpr float EPS = 1e-6f;
constexpr int NTHREADS = 512, NWAVES = 8;
constexpr int LDS_BYTES = 147456;

constexpr size_t MiB = 1u << 20;
constexpr size_t WS_W1A = 0, WS_W2A = 11 * MiB, WS_W1B = WS_W2A + 11 * MiB / 2, WS_W2B = WS_W1B + 11 * MiB,
                 WS_WIN = 33 * MiB, WS_WVT = 43 * MiB, WS_WP = 47 * MiB, WS_WO = 51 * MiB, WS_WG = 53 * MiB,
                 WS_RB = 54 * MiB, WS_GB = 54 * MiB + 512 * 1024, WS_JS = 55 * MiB,
                 WS_XB = 56 * MiB, WS_ZN = 88 * MiB, WS_ZT = 248 * MiB, WS_Y = 312 * MiB, WS_DC = 376 * MiB, WS_BAR = 409 * MiB, WS_CNT = 409 * MiB + 65536, WS_XCH = 410 * MiB, WS_SP = 414 * MiB, WS_XT = 415 * MiB, WS_END = 479 * MiB;
constexpr int BAR_LDS_OFF = LDS_BYTES - 16;

struct Params {
    const float* in[19];
    float* out;
    unsigned char* ws;
};

__device__ __forceinline__ unsigned cvt_pk_bf16(float lo, float hi) { unsigned r; asm volatile("v_cvt_pk_bf16_f32 %0, %1, %2" : "=v"(r) : "v"(lo), "v"(hi)); return r; }
__device__ __forceinline__ float bflo(unsigned w) { return __uint_as_float(w << 16); }
__device__ __forceinline__ float bfhi(unsigned w) { return __uint_as_float(w & 0xffff0000u); }
__device__ __forceinline__ float wave_sum(float v) {
#pragma unroll
    for (int o = 1; o < 64; o <<= 1) v += __shfl_xor(v, o);
    return v;
}
__device__ __forceinline__ float wave_max(float v) {
#pragma unroll
    for (int o = 1; o < 64; o <<= 1) v = fmaxf(v, __shfl_xor(v, o));
    return v;
}
__device__ __forceinline__ float fast_sigmoid(float x) { return __builtin_amdgcn_rcpf(1.0f + __expf(-x)); }
__device__ __forceinline__ float gelu_tanh(float x) { const float u = 0.7978845608028654f * (x + 0.044715f * x * x * x); return x * __builtin_amdgcn_rcpf(1.0f + __expf(-2.0f * u)); }
__device__ __forceinline__ float silu_f(float x) { return x * __builtin_amdgcn_rcpf(1.0f + __expf(-x)); }
#define LDS_WAIT() asm volatile("s_waitcnt lgkmcnt(0)" ::: "memory")

namespace pg8 {
constexpr int BM = 256, BK = 64, HALF = 128, HTB = HALF * BK * 2, STAGE_BYTES = 8 * HTB, NXCD = 8, WGM = 8;
__device__ __forceinline__ int lds_byte(int r, int c) { const int st = (r >> 4) * 2 + (c >> 5), rr = r & 15, cc = c & 31, ob = rr * 64 + cc * 2; return st * 1024 + (ob ^ (((ob >> 9) & 1) << 5)); }
__device__ __forceinline__ void stage_rc(int b, int& R, int& C) { const int st = b / 1024, sb = b % 1024, swz = sb ^ (((sb >> 9) & 1) << 5); R = (st >> 1) * 16 + swz / 64; C = (st & 1) * 32 + (swz % 64) / 2; }
__device__ __forceinline__ int perm32(int rho) { const int n = rho >> 4, i = rho & 15; return 8 * (i >> 2) + 4 * n + (i & 3); }
struct Unit { int pm, pn; };
struct Gemm { const bf16_t* A; const bf16_t* Bt; int M, N, K; };
struct StaticOrder {
    int nM, nN, nwg, G, c;
    __device__ void init(int M, int N, int G_, int c_) { nM = M / BM; nN = N / BM; nwg = nM * nN; G = G_; c = c_; }
    __device__ bool next(int i, Unit& u) const {
        const long L = (long)i * G + c; if (L >= nwg) return false;
        int wgid = (int)L; { const int q = nwg / NXCD, r = nwg % NXCD, xcd = wgid % NXCD, off = wgid / NXCD; wgid = (xcd < r ? xcd * (q + 1) : r * (q + 1) + (xcd - r) * q) + off; }
        const int nig = WGM * nN, gid = wgid / nig, fm = gid * WGM, gsz = (nM - fm) < WGM ? (nM - fm) : WGM;
        u.pm = fm + ((wgid % nig) % gsz); u.pn = (wgid % nig) / gsz; return true;
    }
};

template <class Epi>
__device__ __forceinline__ void gemm_phase(LAS unsigned char* lds, const Gemm g, const StaticOrder& S, const Epi& E, const int tid) {
    const int wid = __builtin_amdgcn_readfirstlane(tid >> 6), lane = tid & 63, wr = wid >> 2, wc = wid & 3, fr = lane & 15, fq = lane >> 4;
    const int K = g.K, nt = K / BK;
    unsigned voffA[2], voffB[2];
#pragma unroll
    for (int i = 0; i < 2; ++i) { int R, C; stage_rc(tid * 16 + i * 8192, R, C); const int Rb = Epi::PERM ? ((R & ~31) + perm32(R & 31)) : R;
        voffA[i] = (unsigned)(R * K + C) * 2u; voffB[i] = (unsigned)(Rb * K + C) * 2u; }
    const size_t kstep = (size_t)(BK * 2);
    const size_t hstep = (size_t)HALF * K * 2;
    const size_t tstep = 2 * hstep;
    const unsigned ldsw = (unsigned)wid * 1024u;
    const int aoff = lds_byte(wr * 64 + fr, fq * 8), boff = lds_byte(wc * 32 + fr, fq * 8);
#define PG8_SA(b, h) (((b) * 2 + (h)) * HTB)
#define PG8_SB(b, h) ((4 + (b) * 2 + (h)) * HTB)
#define PG8_STAGE(bufoff, gbase, voff) do { _Pragma("unroll") for (int _i = 0; _i < 2; ++_i) \
        __builtin_amdgcn_global_load_lds((const unsigned*)((const char*)(gbase) + (voff)[_i]), (LAS unsigned*)(lds + (bufoff) + ldsw + _i * 8192), 16, 0, 0); } while (0)
#define PG8_LDA(dst, b, h) do { _Pragma("unroll") for (int m = 0; m < 4; ++m) _Pragma("unroll") for (int k = 0; k < 2; ++k) dst[m][k] = *(const LAS bf16x8*)(lds + PG8_SA(b, h) + aoff + m * 2048 + k * 1024); } while (0)
#define PG8_LDB(dst, b, h) do { _Pragma("unroll") for (int n = 0; n < 2; ++n) _Pragma("unroll") for (int k = 0; k < 2; ++k) dst[n][k] = *(const LAS bf16x8*)(lds + PG8_SB(b, h) + boff + n * 2048 + k * 1024); } while (0)
#define PG8_MMA(ai, bj, At, Bt) do { __builtin_amdgcn_s_setprio(1); _Pragma("unroll") for (int m = 0; m < 4; ++m) _Pragma("unroll") for (int n = 0; n < 2; ++n) _Pragma("unroll") for (int k = 0; k < 2; ++k) \
        acc[ai][bj][m][n] = __builtin_amdgcn_mfma_f32_16x16x32_bf16(Bt[n][k], At[m][k], acc[ai][bj][m][n], 0, 0, 0); __builtin_amdgcn_s_setprio(0); } while (0)
#define PG8_WAIT_V(n) asm volatile("s_waitcnt vmcnt(" #n ")" ::: "memory")
#define PG8_WAIT_L(n) asm volatile("s_waitcnt lgkmcnt(" #n ")" ::: "memory")
#define PG8_BAR __builtin_amdgcn_s_barrier()
#define PG8_SCHED __builtin_amdgcn_sched_barrier(0)
    Unit cur, nxt; int ui = 0;
    if (!S.next(0, cur)) return;
    f32x4 acc[2][2][4][2];
#pragma unroll
    for (int a = 0; a < 2; ++a)
#pragma unroll
        for (int b = 0; b < 2; ++b)
#pragma unroll
            for (int m = 0; m < 4; ++m)
#pragma unroll
                for (int n = 0; n < 2; ++n) acc[a][b][m][n] = (f32x4){0.f, 0.f, 0.f, 0.f};
    bf16x8 At[4][2], B0[2][2], B1[2][2];
    const char* cA = (const char*)g.A + (size_t)cur.pm * tstep; const char* cB = (const char*)g.Bt + (size_t)cur.pn * tstep;
    PG8_STAGE(PG8_SB(0, 0), cB, voffB); PG8_STAGE(PG8_SA(0, 0), cA, voffA); PG8_STAGE(PG8_SB(0, 1), cB + hstep, voffB); PG8_STAGE(PG8_SA(0, 1), cA + hstep, voffA);
    if (wr == 1) PG8_BAR;
    PG8_WAIT_V(4); PG8_BAR;
    PG8_STAGE(PG8_SB(1, 0), cB + kstep, voffB); PG8_STAGE(PG8_SA(1, 0), cA + kstep, voffA); PG8_STAGE(PG8_SB(1, 1), cB + hstep + kstep, voffB);
    PG8_WAIT_V(6); PG8_BAR;
    for (;;) {
        const bool has_next = S.next(ui + 1, nxt);
        const char* nA = has_next ? (const char*)g.A + (size_t)nxt.pm * tstep : cA; const char* nB = has_next ? (const char*)g.Bt + (size_t)nxt.pn * tstep : cB;
        for (int t = 0; t < nt; t += 2) {
            const bool last = (t == nt - 2);
            const char* a1 = cA + (size_t)(t + 1) * kstep;
            const char* a2 = last ? nA : cA + (size_t)(t + 2) * kstep; const char* b2 = last ? nB : cB + (size_t)(t + 2) * kstep;
            const char* a3 = a2 + kstep; const char* b3 = b2 + kstep;
            if constexpr (Epi::HAS_MID) { if (t == nt / 2) E.mid(acc, cur, wr, wc, fr, fq); }
            PG8_LDB(B0, 0, 0); PG8_SCHED; PG8_LDA(At, 0, 0); PG8_STAGE(PG8_SA(1, 1), a1 + hstep, voffA);
            PG8_WAIT_L(8); PG8_BAR; PG8_WAIT_L(0); PG8_MMA(0, 0, At, B0); PG8_BAR; PG8_SCHED;
            PG8_LDB(B1, 0, 1); PG8_STAGE(PG8_SB(0, 0), b2, voffB);
            PG8_BAR; PG8_WAIT_L(0); PG8_MMA(0, 1, At, B1); PG8_BAR;
            PG8_LDA(At, 0, 1); PG8_STAGE(PG8_SA(0, 0), a2, voffA);
            PG8_BAR; PG8_WAIT_L(0); PG8_MMA(1, 0, At, B0); PG8_BAR; PG8_SCHED;
            PG8_STAGE(PG8_SB(0, 1), b2 + hstep, voffB);
            PG8_WAIT_V(6); PG8_BAR; PG8_MMA(1, 1, At, B1); PG8_BAR;
            PG8_LDB(B0, 1, 0); PG8_SCHED; PG8_LDA(At, 1, 0); PG8_STAGE(PG8_SA(0, 1), a2 + hstep, voffA);
            PG8_WAIT_L(8); PG8_BAR; PG8_WAIT_L(0); PG8_MMA(0, 0, At, B0); PG8_BAR; PG8_SCHED;
            PG8_LDB(B1, 1, 1); PG8_STAGE(PG8_SB(1, 0), b3, voffB);
            PG8_BAR; PG8_WAIT_L(0); PG8_MMA(0, 1, At, B1); PG8_BAR;
            PG8_LDA(At, 1, 1); PG8_STAGE(PG8_SA(1, 0), a3, voffA);
            PG8_BAR; PG8_WAIT_L(0); PG8_MMA(1, 0, At, B0); PG8_BAR; PG8_SCHED;
            PG8_STAGE(PG8_SB(1, 1), b3 + hstep, voffB);
            PG8_WAIT_V(6); PG8_BAR; PG8_MMA(1, 1, At, B1); PG8_BAR;
        }
        if constexpr (!Epi::AFTER_DRAIN) E(acc, cur, wr, wc, fr, fq);
        if (!has_next) break;
#pragma unroll
        for (int a = 0; a < 2; ++a)
#pragma unroll
            for (int b = 0; b < 2; ++b)
#pragma unroll
                for (int m = 0; m < 4; ++m)
#pragma unroll
                    for (int n = 0; n < 2; ++n) acc[a][b][m][n] = (f32x4){0.f, 0.f, 0.f, 0.f};
        cur = nxt; cA = nA; cB = nB; ++ui;
    }
    PG8_WAIT_V(0);
    if (wr == 0) PG8_BAR;
    PG8_BAR;
    if constexpr (Epi::AFTER_DRAIN) E.fused(acc, cur, wr, wc, fr, fq, lds, tid, wid, lane);
#undef PG8_SA
#undef PG8_SB
#undef PG8_STAGE
#undef PG8_LDA
#undef PG8_LDB
#undef PG8_MMA
#undef PG8_WAIT_V
#undef PG8_WAIT_L
#undef PG8_BAR
#undef PG8_SCHED
}

struct EpiSwiGLU {
    static constexpr bool PERM = true, HAS_MID = false, AFTER_DRAIN = false;
    bf16_t* O; const float* rs;
    __device__ __forceinline__ void mid(f32x4 (&)[2][2][4][2], const Unit&, int, int, int, int) const {}
    __device__ __forceinline__ void operator()(const f32x4 (&acc)[2][2][4][2], const Unit& u, int wr, int wc, int fr, int fq) const {
        const int row0 = u.pm * BM + wr * 64 + fr, col0 = u.pn * 128 + wc * 32 + 8 * fq;
#pragma unroll
        for (int ai = 0; ai < 2; ++ai)
#pragma unroll
            for (int m = 0; m < 4; ++m) {
                const int row = row0 + ai * HALF + m * 16;
                float o[8];
#pragma unroll
                for (int n = 0; n < 2; ++n)
#pragma unroll
                    for (int j = 0; j < 4; ++j) { const float a = acc[ai][0][m][n][j], gg = acc[ai][1][m][n][j]; o[n * 4 + j] = silu_f(a) * gg; }
                u32x4 w; w.x = cvt_pk_bf16(o[0], o[1]); w.y = cvt_pk_bf16(o[2], o[3]); w.z = cvt_pk_bf16(o[4], o[5]); w.w = cvt_pk_bf16(o[6], o[7]);
                *(u32x4*)(O + (size_t)row * DFF + col0) = w;
            }
    }
};
struct EpiZ {
    static constexpr bool PERM = true, HAS_MID = false, AFTER_DRAIN = false;
    bf16_t* O; const float* rs;
    __device__ __forceinline__ void mid(f32x4 (&)[2][2][4][2], const Unit&, int, int, int, int) const {}
    __device__ __forceinline__ void operator()(const f32x4 (&acc)[2][2][4][2], const Unit& u, int wr, int wc, int fr, int fq) const {
        const int row0 = u.pm * BM + wr * 64 + fr, col0 = u.pn * BM + wc * 32 + 8 * fq;
        const int act = (u.pn < 4) ? 0 : ((u.pn >= 8 && u.pn < 12) ? 2 : 1);
#pragma unroll
        for (int ai = 0; ai < 2; ++ai)
#pragma unroll
            for (int m = 0; m < 4; ++m) {
                const int row = row0 + ai * HALF + m * 16;
#pragma unroll
                for (int bj = 0; bj < 2; ++bj) {
                    float o[8];
#pragma unroll
                    for (int n = 0; n < 2; ++n)
#pragma unroll
                        for (int j = 0; j < 4; ++j) { float v = acc[ai][bj][m][n][j]; if (act == 1) v = fast_sigmoid(v); else if (act == 2) v = gelu_tanh(v); o[n * 4 + j] = v; }
                    u32x4 w; w.x = cvt_pk_bf16(o[0], o[1]); w.y = cvt_pk_bf16(o[2], o[3]); w.z = cvt_pk_bf16(o[4], o[5]); w.w = cvt_pk_bf16(o[6], o[7]);
                    *(u32x4*)(O + (size_t)row * ZN + col0 + bj * HALF) = w;
                }
            }
    }
};
struct EpiZT {
    static constexpr bool PERM = true, HAS_MID = false, AFTER_DRAIN = false;
    bf16_t* O; const float* rs; float* SP;
    __device__ __forceinline__ void mid(f32x4 (&)[2][2][4][2], const Unit&, int, int, int, int) const {}
    __device__ __forceinline__ void operator()(const f32x4 (&acc)[2][2][4][2], const Unit& u, int wr, int wc, int fr, int fq) const {
        const int row0 = u.pm * BM + wr * 64 + fr, col0 = u.pn * BM + wc * 32 + 8 * fq;
        const bool gel = (u.pm >= 4);
        float cs[32];
#pragma unroll
        for (int i = 0; i < 32; ++i) cs[i] = 0.f;
#pragma unroll
        for (int ai = 0; ai < 2; ++ai)
#pragma unroll
            for (int m = 0; m < 4; ++m) {
                const int row = row0 + ai * HALF + m * 16;
#pragma unroll
                for (int bj = 0; bj < 2; ++bj) {
                    float o[8];
#pragma unroll
                    for (int n = 0; n < 2; ++n)
#pragma unroll
                        for (int j = 0; j < 4; ++j) { float v = acc[ai][bj][m][n][j]; if (gel) v = gelu_tanh(v); o[n * 4 + j] = v; }
                    u32x4 w; w.x = cvt_pk_bf16(o[0], o[1]); w.y = cvt_pk_bf16(o[2], o[3]); w.z = cvt_pk_bf16(o[4], o[5]); w.w = cvt_pk_bf16(o[6], o[7]);
                    *(u32x4*)(O + (size_t)row * NTOK + col0 + bj * HALF) = w;
                    if (gel) {
#pragma unroll
                        for (int e = 0; e < 8; ++e) { cs[bj * 8 + e] += o[e]; cs[16 + bj * 8 + e] += o[e] * o[e]; }
                    }
                }
            }
        if (gel) {
            float t8[16], t4[8], t2[4], t1[2];
            { const bool hi = (fr >> 3) & 1;
#pragma unroll
              for (int i = 0; i < 16; ++i) { const float keep = hi ? cs[16 + i] : cs[i], send = hi ? cs[i] : cs[16 + i]; t8[i] = keep + __shfl_xor(send, 8); } }
            { const bool hi = (fr >> 2) & 1;
#pragma unroll
              for (int i = 0; i < 8; ++i) { const float keep = hi ? t8[8 + i] : t8[i], send = hi ? t8[i] : t8[8 + i]; t4[i] = keep + __shfl_xor(send, 4); } }
            { const bool hi = (fr >> 1) & 1;
#pragma unroll
              for (int i = 0; i < 4; ++i) { const float keep = hi ? t4[4 + i] : t4[i], send = hi ? t4[i] : t4[4 + i]; t2[i] = keep + __shfl_xor(send, 2); } }
            { const bool hi = fr & 1;
#pragma unroll
              for (int i = 0; i < 2; ++i) { const float keep = hi ? t2[2 + i] : t2[i], send = hi ? t2[i] : t2[2 + i]; t1[i] = keep + __shfl_xor(send, 1); } }
            const int f7 = fr & 7, tok = u.pn * BM + (f7 >> 2) * HALF + wc * 32 + 8 * fq + 4 * ((f7 >> 1) & 1) + 2 * (f7 & 1);
            *(f32x2*)(SP + (size_t)((fr >> 3) * 8 + (u.pm - 4) * 2 + wr) * NTOK + tok) = (f32x2){t1[0], t1[1]};
        }
    }
};
template <int NV>
__device__ __forceinline__ void panel_exchange(LAS float* P, LAS float* S, unsigned* xbuf, unsigned* cnt, int pm, int pn, int tid, int wid, int lane) {
    asm volatile("s_waitcnt lgkmcnt(0)" ::: "memory"); __builtin_amdgcn_s_barrier(); asm volatile("" ::: "memory");
    if (tid < 256) {
        unsigned* slot = xbuf + ((size_t)(pm * 256 + tid) * 4 + pn) * NV;
#pragma unroll
        for (int v = 0; v < NV; ++v) { const float t = (P[(tid * 4 + 0) * NV + v] + P[(tid * 4 + 1) * NV + v]) + (P[(tid * 4 + 2) * NV + v] + P[(tid * 4 + 3) * NV + v]);
            __hip_atomic_store(slot + v, __float_as_uint(t), __ATOMIC_RELAXED, __HIP_MEMORY_SCOPE_AGENT); }
    }
    asm volatile("s_waitcnt vmcnt(0)" ::: "memory");
    if (lane == 0) __hip_atomic_fetch_add(cnt + 64 * pm, 1u, __ATOMIC_RELAXED, __HIP_MEMORY_SCOPE_AGENT);
    if (wid == 0) {
        unsigned spins = 0;
        while ((unsigned)__builtin_amdgcn_readfirstlane(__hip_atomic_load(cnt + 64 * pm, __ATOMIC_RELAXED, __HIP_MEMORY_SCOPE_AGENT)) < 32u) { __builtin_amdgcn_s_sleep(2); if (++spins > (1u << 22)) break; }
        __builtin_amdgcn_fence(__ATOMIC_ACQUIRE, "agent");
    }
    asm volatile("s_waitcnt vmcnt(0) lgkmcnt(0)" ::: "memory"); __builtin_amdgcn_s_barrier(); asm volatile("" ::: "memory");
    if (tid < 256) {
        const unsigned* slot = xbuf + (size_t)(pm * 256 + tid) * 4 * NV;
#pragma unroll
        for (int v = 0; v < NV; ++v) { float t = 0.f;
#pragma unroll
            for (int q = 0; q < 4; ++q) t += __uint_as_float(__hip_atomic_load(slot + q * NV + v, __ATOMIC_RELAXED, __HIP_MEMORY_SCOPE_AGENT));
            S[tid * NV + v] = t; }
    }
    asm volatile("s_waitcnt vmcnt(0) lgkmcnt(0)" ::: "memory"); __builtin_amdgcn_s_barrier(); asm volatile("" ::: "memory");
}
template <bool GATES> struct EpiRes {
    static constexpr bool PERM = false, HAS_MID = false, AFTER_DRAIN = true;
    static constexpr int NV2 = GATES ? 9 : 1;
    const float* Xin; float* X; int in_t, out_t; bf16_t* XB; float* RB; float* GB; const float* gain; float scale; const float* wg; const float* ibias; const float* fbias;
    unsigned* xch1; unsigned* xch2; unsigned* cnt1; unsigned* cnt2;
    __device__ __forceinline__ void mid(f32x4 (&)[2][2][4][2], const Unit&, int, int, int, int) const {}
    __device__ __forceinline__ void operator()(const f32x4 (&)[2][2][4][2], const Unit&, int, int, int, int) const {}
    __device__ __forceinline__ void fused(f32x4 (&acc)[2][2][4][2], const Unit& u, int wr, int wc, int fr, int fq, LAS unsigned char* lds, int tid, int wid, int lane) const {
        LAS float* P = (LAS float*)lds; LAS float* S = (LAS float*)(lds + 40960);
        const int rl0 = wr * 64 + fr, col0 = u.pn * BM + wc * 32 + 4 * fq;
#pragma unroll
        for (int ai = 0; ai < 2; ++ai)
#pragma unroll
            for (int m = 0; m < 4; ++m) { float q = 0.f;
#pragma unroll
                for (int bj = 0; bj < 2; ++bj)
#pragma unroll
                    for (int n = 0; n < 2; ++n) { const f32x4 d = acc[ai][bj][m][n]; q += (d[0] * d[0] + d[1] * d[1]) + (d[2] * d[2] + d[3] * d[3]); }
                q += __shfl_xor(q, 16); q += __shfl_xor(q, 32);
                if (fq == 0) P[(ai * HALF + rl0 + m * 16) * 4 + wc] = q; }
        panel_exchange<1>(P, S, xch1, cnt1, u.pm, u.pn, tid, wid, lane);
        {
            const size_t rm0 = (size_t)(u.pm * BM + rl0) * DM + col0, tl0 = ((size_t)((u.pm * 4 + u.pn) * 8 + wid) * 32 * 64 + lane) * 4;
            const size_t ia0 = in_t ? tl0 : rm0, oa0 = out_t ? tl0 : rm0;
            const int isa = in_t ? 4096 : HALF * DM, ism = in_t ? 1024 : 16 * DM, isb = in_t ? 512 : HALF, isn = in_t ? 256 : 16;
            const int osa = out_t ? 4096 : HALF * DM, osm = out_t ? 1024 : 16 * DM, osb = out_t ? 512 : HALF, osn = out_t ? 256 : 16;
            f32x4 gv[2][2];
#pragma unroll
            for (int bj = 0; bj < 2; ++bj)
#pragma unroll
                for (int n = 0; n < 2; ++n) gv[bj][n] = *(const f32x4*)(gain + col0 + bj * HALF + n * 16);
#pragma unroll
            for (int ai = 0; ai < 2; ++ai)
#pragma unroll
                for (int mh = 0; mh < 2; ++mh) {
                    f32x4 xv[2][2][2];
#pragma unroll
                    for (int mm = 0; mm < 2; ++mm) {
#pragma unroll
                        for (int bj = 0; bj < 2; ++bj)
#pragma unroll
                            for (int n = 0; n < 2; ++n) xv[mm][bj][n] = *(const f32x4*)(Xin + ia0 + (unsigned)(ai * isa + (mh * 2 + mm) * ism + bj * isb + n * isn)); }
#pragma unroll
                    for (int mm = 0; mm < 2; ++mm) { const int m = mh * 2 + mm, rl = ai * HALF + rl0 + m * 16; const float ry = scale * rsqrtf(S[rl] * (1.0f / DM) + EPS);
#pragma unroll
                        for (int bj = 0; bj < 2; ++bj)
#pragma unroll
                            for (int n = 0; n < 2; ++n) { const f32x4 xn = xv[mm][bj][n] + acc[ai][bj][m][n] * gv[bj][n] * ry;
                                acc[ai][bj][m][n] = xn; *(f32x4*)(X + oa0 + (unsigned)(ai * osa + m * osm + bj * osb + n * osn)) = xn; }
                        asm volatile("" : "+v"(acc[ai][0][m][0]), "+v"(acc[ai][0][m][1]), "+v"(acc[ai][1][m][0]), "+v"(acc[ai][1][m][1])); }
                    asm volatile("" ::: "memory"); }
        }
#pragma unroll
        for (int ai = 0; ai < 2; ++ai)
#pragma unroll
            for (int m = 0; m < 4; ++m) { float q = 0.f;
#pragma unroll
                for (int bj = 0; bj < 2; ++bj)
#pragma unroll
                    for (int n = 0; n < 2; ++n) { const f32x4 d = acc[ai][bj][m][n]; q += (d[0] * d[0] + d[1] * d[1]) + (d[2] * d[2] + d[3] * d[3]); }
                q += __shfl_xor(q, 16); q += __shfl_xor(q, 32);
                if (fq == 0) P[((ai * HALF + rl0 + m * 16) * 4 + wc) * NV2] = q; }
        if constexpr (GATES) {
#pragma unroll 2
            for (int j = 0; j < 8; ++j) {
                f32x4 wv[2][2];
#pragma unroll
                for (int bj = 0; bj < 2; ++bj)
#pragma unroll
                    for (int n = 0; n < 2; ++n) wv[bj][n] = *(const f32x4*)(wg + j * DM + col0 + bj * HALF + n * 16);
#pragma unroll
                for (int ai = 0; ai < 2; ++ai)
#pragma unroll
                    for (int m = 0; m < 4; ++m) { float q = 0.f;
#pragma unroll
                        for (int bj = 0; bj < 2; ++bj)
#pragma unroll
                            for (int n = 0; n < 2; ++n) { const f32x4 d = acc[ai][bj][m][n], w = wv[bj][n]; q += (d[0] * w[0] + d[1] * w[1]) + (d[2] * w[2] + d[3] * w[3]); }
                        q += __shfl_xor(q, 16); q += __shfl_xor(q, 32);
                        if (fq == 0) P[((ai * HALF + rl0 + m * 16) * 4 + wc) * NV2 + 1 + j] = q; }
            }
        }
        panel_exchange<NV2>(P, S, xch2, cnt2, u.pm, u.pn, tid, wid, lane);
#pragma unroll
        for (int ai = 0; ai < 2; ++ai)
#pragma unroll
            for (int m = 0; m < 4; ++m) { const int rl = ai * HALF + rl0 + m * 16; const float r = rsqrtf(S[rl * NV2] * (1.0f / DM) + EPS);
                const bool odd = (fq & 1) != 0;
                const size_t off = (size_t)(u.pm * BM + rl) * DM + u.pn * BM + wc * 32 + (odd ? 16 + 4 * (fq - 1) : 4 * fq);
#pragma unroll
                for (int bj = 0; bj < 2; ++bj) { const f32x4 x0 = acc[ai][bj][m][0] * r, x1 = acc[ai][bj][m][1] * r;
                    const unsigned p0x = cvt_pk_bf16(x0[0], x0[1]), p0y = cvt_pk_bf16(x0[2], x0[3]), p1x = cvt_pk_bf16(x1[0], x1[1]), p1y = cvt_pk_bf16(x1[2], x1[3]);
                    const unsigned rx = (unsigned)__shfl_xor((int)(odd ? p0x : p1x), 16), ry = (unsigned)__shfl_xor((int)(odd ? p0y : p1y), 16);
                    u32x4 w; w.x = odd ? rx : p0x; w.y = odd ? ry : p0y; w.z = odd ? p1x : rx; w.w = odd ? p1y : ry;
                    *(u32x4*)(XB + off + bj * HALF) = w; } }
        if (GATES && u.pn == 0 && tid < 256) {
            const int row = u.pm * BM + tid; const float r = rsqrtf(S[tid * NV2] * (1.0f / DM) + EPS);
            if constexpr (GATES) {
#pragma unroll
                for (int j = 0; j < 8; ++j) { float v = S[tid * NV2 + 1 + j] * r;
                    if (j < 4) v += ibias[j]; else { v += fbias[j - 4]; v = fminf(v, 0.f) - log1pf(expf(-fabsf(v))); }
                    GB[(size_t)row * 8 + j] = v; }
            }
        }
    }
};
struct EpiMerge {
    static constexpr bool PERM = true, HAS_MID = true, AFTER_DRAIN = false;
    bf16_t* O; const bf16_t* zn;
    __device__ __forceinline__ void mid(f32x4 (&acc)[2][2][4][2], const Unit& u, int wr, int wc, int fr, int fq) const {
        unsigned off0 = (unsigned)((u.pm * BM + wr * 64 + fr) * ZN + u.pn * BM + wc * 32 + 8 * fq) * 2u;
        asm volatile("" : "+v"(off0));
#pragma unroll
        for (int ai = 0; ai < 2; ++ai) {
            u32x4 sa[4][2], sb[4][2];
#pragma unroll
            for (int m = 0; m < 4; ++m) { const bf16_t* zr = (const bf16_t*)((const char*)zn + off0 + (unsigned)((ai * HALF + m * 16) * ZN * 2));
#pragma unroll
                for (int bj = 0; bj < 2; ++bj) { sa[m][bj] = *(const u32x4*)(zr + 3072 + bj * HALF); sb[m][bj] = *(const u32x4*)(zr + 4096 + bj * HALF); } }
#pragma unroll
            for (int m = 0; m < 4; ++m)
#pragma unroll
                for (int bj = 0; bj < 2; ++bj) {
                    const unsigned saw[4] = {sa[m][bj].x, sa[m][bj].y, sa[m][bj].z, sa[m][bj].w}, sbw[4] = {sb[m][bj].x, sb[m][bj].y, sb[m][bj].z, sb[m][bj].w};
#pragma unroll
                    for (int n = 0; n < 2; ++n)
#pragma unroll
                        for (int j = 0; j < 4; ++j) {
                            const int e = n * 4 + j; const unsigned wa = saw[e >> 1], wb = sbw[e >> 1];
                            const float a = (e & 1) ? bfhi(wa) : bflo(wa), b = (e & 1) ? bfhi(wb) : bflo(wb);
                            acc[ai][bj][m][n][j] *= a * __builtin_amdgcn_rcpf(b);
                        }
                }
            asm volatile("" ::: "memory");
        }
    }
    __device__ __forceinline__ void operator()(const f32x4 (&acc)[2][2][4][2], const Unit& u, int wr, int wc, int fr, int fq) const {
        const int row0 = u.pm * BM + wr * 64 + fr, col0 = u.pn * BM + wc * 32 + 8 * fq;
#pragma unroll
        for (int ai = 0; ai < 2; ++ai) {
            u32x4 sb[4][2];
#pragma unroll
            for (int m = 0; m < 4; ++m)
#pragma unroll
                for (int bj = 0; bj < 2; ++bj) sb[m][bj] = *(const u32x4*)(zn + (size_t)(row0 + ai * HALF + m * 16) * ZN + col0 + 4096 + bj * HALF);
#pragma unroll
            for (int m = 0; m < 4; ++m) {
                const int row = row0 + ai * HALF + m * 16;
#pragma unroll
                for (int bj = 0; bj < 2; ++bj) {
                    const unsigned sbw[4] = {sb[m][bj].x, sb[m][bj].y, sb[m][bj].z, sb[m][bj].w};
                    float o[8];
#pragma unroll
                    for (int n = 0; n < 2; ++n)
#pragma unroll
                        for (int j = 0; j < 4; ++j) { const int e = n * 4 + j; const unsigned wb = sbw[e >> 1]; o[e] = acc[ai][bj][m][n][j] * ((e & 1) ? bfhi(wb) : bflo(wb)); }
                    u32x4 w; w.x = cvt_pk_bf16(o[0], o[1]); w.y = cvt_pk_bf16(o[2], o[3]); w.z = cvt_pk_bf16(o[4], o[5]); w.w = cvt_pk_bf16(o[6], o[7]);
                    *(u32x4*)(O + (size_t)row * DM + col0 + bj * HALF) = w;
                }
            }
        }
    }
};
}

__device__ __forceinline__ void conv_item(const float* W, int ldw, int src_col0, int k0, const float* gain, bf16_t* dst, int dst_ld, int dst_row0, int dst_k0, float* scr, int lane) {
    asm volatile("" : "+v"(W), "+v"(dst));
    const int lr = lane >> 3, lc = (lane & 7) * 4;
    f32x4 v[8]; float gk[8];
#pragma unroll
    for (int i = 0; i < 8; ++i) { const int kk = 8 * i + lr; v[i] = *(const f32x4*)(W + (unsigned)((k0 + kk) * ldw + src_col0 + lc)); gk[i] = gain ? gain[k0 + kk] : 1.0f; }
#pragma unroll
    for (int i = 0; i < 8; ++i) { const int kk = 8 * i + lr; float* d = scr + kk * 33 + lc; d[0] = v[i][0] * gk[i]; d[1] = v[i][1] * gk[i]; d[2] = v[i][2] * gk[i]; d[3] = v[i][3] * gk[i]; }
    LDS_WAIT();
    const int c = lane & 7;
#pragma unroll
    for (int j = 0; j < 4; ++j) { const int n = (lane >> 3) + 8 * j; const float* s = scr + (8 * c) * 33 + n;
        u32x4 o; o.x = cvt_pk_bf16(s[0 * 33], s[1 * 33]); o.y = cvt_pk_bf16(s[2 * 33], s[3 * 33]); o.z = cvt_pk_bf16(s[4 * 33], s[5 * 33]); o.w = cvt_pk_bf16(s[6 * 33], s[7 * 33]);
        *(u32x4*)(dst + (unsigned)((dst_row0 + n) * dst_ld + dst_k0 + k0 + 8 * c)) = o; }
    LDS_WAIT();
}

__device__ __forceinline__ void convert_layer(const Params& pp, int lA, int lB, unsigned char* lds, int gw, int NGW, int lane, int wave) {
    Params p;
#define LND(a) { const float* t = pp.in[a]; asm volatile("" : "+s"(t)); p.in[a] = t; }
    LND(1) LND(2) LND(3) LND(4) LND(14) LND(15) LND(16) LND(17) LND(18)
#undef LND
    { unsigned char* t = pp.ws; asm volatile("" : "+s"(t)); p.ws = t; }
    float* scr = (float*)(lds + wave * 8448);
    unsigned char* ws = p.ws;
    constexpr int I_F1 = 16 * 176, I_F2 = 44 * 32, I_WN = 16 * 160, I_WT = 16 * 64, I_P = 16 * 32;
    constexpr int NA = I_F1 + I_F2 + I_WN + I_WT, NB = I_F1 + I_F2 + 3 * I_P;
    const int it_lo = (lA >= 0) ? 0 : NA, it_hi = (lB >= 0) ? NA + NB : NA;
    for (int it = it_lo + gw; it < it_hi; it += NGW) {
        const bool f = it >= NA; int r = f ? it - NA : it; const int l = f ? lB : lA;
        const float* gains = p.in[1] + (size_t)l * 6 * DM; asm volatile("" : "+v"(gains));
        if (r < I_F1) {
            const int kb = r / 176, nb = r % 176, j = nb * 32;
            const int src = ((j >> 7) & 1) * DFF + (j >> 8) * 128 + (j & 127);
            conv_item((f ? p.in[17] : p.in[2]) + (size_t)l * DM * 2 * DFF, 2 * DFF, src, kb * 64, gains + (f ? 4 : 0) * DM, (bf16_t*)(ws + (f ? WS_W1B : WS_W1A)), DM, j, 0, scr, lane);
            continue;
        }
        r -= I_F1;
        if (r < I_F2) {
            const int kb = r / 32, nb = r % 32;
            conv_item((f ? p.in[18] : p.in[3]) + (size_t)l * DFF * DM, DM, nb * 32, kb * 64, nullptr, (bf16_t*)(ws + (f ? WS_W2B : WS_W2A)), DFF, nb * 32, 0, scr, lane);
            continue;
        }
        r -= I_F2;
        if (!f) {
            const float* win = p.in[4] + (size_t)l * DM * WIN_COLS;
            if (r < I_WN) {
                const int kb = r / 160, nb = r % 160, j = nb * 32;
                const int src = (j < 1024) ? j : ((j < 3072) ? (j - 1024 + 2056) : (j - 3072 + 5128));
                conv_item(win, WIN_COLS, src, kb * 64, gains + 2 * DM, (bf16_t*)(ws + WS_WIN), DM, j, 0, scr, lane);
                continue;
            }
            r -= I_WN;
            {
                const int kb = r / 64, nb = r % 64, j = nb * 32;
                const int src = (j < 1024) ? (1024 + j) : (4104 + (j - 1024));
                conv_item(win, WIN_COLS, src, kb * 64, gains + 2 * DM, (bf16_t*)(ws + WS_WVT), DM, j, 0, scr, lane);
            }
        } else {
            const int which = r / I_P; r -= which * I_P; const int kb = r / 32, nb = r % 32;
            const float* src = (which == 0 ? p.in[14] : (which == 1 ? p.in[15] : p.in[16])) + (size_t)l * DM * DM;
            if (which < 2) conv_item(src, DM, nb * 32, kb * 64, nullptr, (bf16_t*)(ws + WS_WP), 2 * DM, nb * 32, which * DM, scr, lane);
            else conv_item(src, DM, nb * 32, kb * 64, nullptr, (bf16_t*)(ws + WS_WO), DM, nb * 32, 0, scr, lane);
        }
    }
    if (lA >= 0) {
        const float* gains = p.in[1] + (size_t)lA * 6 * DM; const float* win = p.in[4] + (size_t)lA * DM * WIN_COLS; float* wg = (float*)(ws + WS_WG); asm volatile("" : "+v"(win), "+v"(wg), "+v"(gains));
        for (int id = gw * 64 + lane; id < 8 * DM; id += NGW * 64) { const int j = id >> 10, k = id & 1023; wg[id] = gains[2 * DM + k] * win[(size_t)k * WIN_COLS + 2048 + j]; }
    }
}

template <int MODE, bool GATES>
__device__ __forceinline__ void ew_phase(const Params& p, int l, const float* src, const float* gain, float scale, int gw, int NGW, int lane) {
    float* X = p.out; bf16_t* XB = (bf16_t*)(p.ws + WS_XB); float* RB = (float*)(p.ws + WS_RB); float* GB = (float*)(p.ws + WS_GB);
    const float* wg = (const float*)(p.ws + WS_WG);
    asm volatile("" : "+v"(X), "+v"(XB), "+v"(src), "+v"(wg));
    for (int row = gw; row < NTOK; row += NGW) {
        f32x4 xv[4];
        if (MODE == 0) {
#pragma unroll
            for (int j = 0; j < 4; ++j) xv[j] = *(const f32x4*)(src + (size_t)row * DM + 256 * j + 4 * lane);
        } else {
            f32x4 yv[4]; float ss = 0.f;
#pragma unroll
            for (int j = 0; j < 4; ++j) { yv[j] = *(const f32x4*)(src + (size_t)row * DM + 256 * j + 4 * lane); xv[j] = *(const f32x4*)(X + (size_t)row * DM + 256 * j + 4 * lane);
                ss += (yv[j][0] * yv[j][0] + yv[j][1] * yv[j][1]) + (yv[j][2] * yv[j][2] + yv[j][3] * yv[j][3]); }
            const float ry = scale * rsqrtf(wave_sum(ss) * (1.0f / DM) + EPS);
#pragma unroll
            for (int j = 0; j < 4; ++j) { const f32x4 gv = *(const f32x4*)(gain + 256 * j + 4 * lane); xv[j] += yv[j] * gv * ry; }
        }
        float sx = 0.f;
#pragma unroll
        for (int j = 0; j < 4; ++j) {
            sx += (xv[j][0] * xv[j][0] + xv[j][1] * xv[j][1]) + (xv[j][2] * xv[j][2] + xv[j][3] * xv[j][3]);
        }
        const float r = rsqrtf(wave_sum(sx) * (1.0f / DM) + EPS);
#pragma unroll
        for (int j = 0; j < 4; ++j) { u32x2 w; w.x = cvt_pk_bf16(xv[j][0] * r, xv[j][1] * r); w.y = cvt_pk_bf16(xv[j][2] * r, xv[j][3] * r);
            *(u32x2*)(XB + (size_t)row * DM + 256 * j + 4 * lane) = w; }
        if (GATES) {
            float mine = 0.f;
#pragma unroll
            for (int g8 = 0; g8 < 8; ++g8) {
                float d = 0.f;
#pragma unroll
                for (int j = 0; j < 4; ++j) { const f32x4 wv = *(const f32x4*)(wg + g8 * DM + 256 * j + 4 * lane); d += (xv[j][0] * wv[0] + xv[j][1] * wv[1]) + (xv[j][2] * wv[2] + xv[j][3] * wv[3]); }
                d = wave_sum(d);
                if (lane == g8) mine = d;
            }
            if (lane < 8) {
                float v = mine * r;
                if (lane < 4) v += p.in[7][l * 4 + lane];
                else { v += p.in[8][l * 4 + (lane - 4)]; v = fminf(v, 0.f) - log1pf(expf(-fabsf(v))); }
                GB[(size_t)row * 8 + lane] = v;
            }
        }
    }
}

__device__ __forceinline__ u32x4 t21_pair(u32x2 a, u32x2 b, bool odd) {
    const unsigned rx = (unsigned)__shfl_xor((int)(odd ? a.x : b.x), 16), ry = (unsigned)__shfl_xor((int)(odd ? a.y : b.y), 16);
    u32x4 w; w.x = odd ? rx : a.x; w.y = odd ? ry : a.y; w.z = odd ? b.x : rx; w.w = odd ? b.y : ry; return w;
}
__device__ __forceinline__ void ew0_phase(const Params& p, const float* src, int gw, int NGW, int lane) {
    bf16_t* XB = (bf16_t*)(p.ws + WS_XB);
    asm volatile("" : "+v"(XB), "+v"(src));
    for (int r0 = gw; r0 < NTOK; r0 += 4 * NGW) {
        f32x4 xv[4][4];
#pragma unroll
        for (int q = 0; q < 4; ++q) { const int row = r0 + q * NGW;
#pragma unroll
            for (int j = 0; j < 4; ++j) xv[q][j] = (row < NTOK) ? *(const f32x4*)(src + (size_t)row * DM + 256 * j + 4 * lane) : (f32x4){0.f, 0.f, 0.f, 0.f}; }
#pragma unroll
        for (int q = 0; q < 4; ++q) { const int row = r0 + q * NGW; float sx = 0.f;
#pragma unroll
            for (int j = 0; j < 4; ++j) sx += (xv[q][j][0] * xv[q][j][0] + xv[q][j][1] * xv[q][j][1]) + (xv[q][j][2] * xv[q][j][2] + xv[q][j][3] * xv[q][j][3]);
            const float r = rsqrtf(wave_sum(sx) * (1.0f / DM) + EPS);
            if (row < NTOK) {
#pragma unroll
                for (int j = 0; j < 4; ++j) { u32x2 w; w.x = cvt_pk_bf16(xv[q][j][0] * r, xv[q][j][1] * r); w.y = cvt_pk_bf16(xv[q][j][2] * r, xv[q][j][3] * r);
                    *(u32x2*)(XB + (size_t)row * DM + 256 * j + 4 * lane) = w; } } }
    }
}
constexpr int PB = 272;
__device__ __forceinline__ bf16x8 ldfrag(const unsigned char* base, int row0, int ks, int lane) { return *(const bf16x8*)(base + (row0 + (lane & 15)) * PB + ks * 64 + (lane >> 4) * 16); }
__device__ __forceinline__ float scan_sum(float v, int lane) {
#pragma unroll
    for (int o = 1; o < 64; o <<= 1) { const float t = __shfl_up(v, o); if (lane >= o) v += t; }
    return v;
}
__device__ __forceinline__ float scan_max(float v, int lane) {
#pragma unroll
    for (int o = 1; o < 64; o <<= 1) { const float t = __shfl_up(v, o); if (lane >= o) v = fmaxf(v, t); }
    return v;
}
__device__ __forceinline__ void conv8(const u32x4 (&r)[5], int first, const float (&cw)[4][8], const float (&cb)[8], float (&o)[8]) {
#pragma unroll
    for (int e = 0; e < 8; ++e) {
        float a = cb[e];
#pragma unroll
        for (int j = 0; j < 4; ++j) { const u32x4 w = r[first + j]; const unsigned ww = (e >> 1) == 0 ? w.x : ((e >> 1) == 1 ? w.y : ((e >> 1) == 2 ? w.z : w.w)); a += cw[j][e] * ((e & 1) ? bfhi(ww) : bflo(ww)); }
        o[e] = silu_f(a);
    }
}

__device__ __forceinline__ void load_vt(unsigned char* dstl, const bf16_t* ZT, int zt_row0, int tok0, int tid) {
#pragma unroll
    for (int i = 0; i < 8; ++i) { const int q = tid + 512 * i, v = q >> 4, ch = q & 15;
        *(u32x4*)(dstl + v * PB + ch * 16) = *(const u32x4*)(ZT + (size_t)(zt_row0 + v) * NTOK + tok0 + ch * 8); }
    if (tid < 256) { const int v = 256 + (tid >> 4), ch = tid & 15; const unsigned f = (v == 256) ? 0x3F803F80u : 0u; *(u32x4*)(dstl + v * PB + ch * 16) = (u32x4){f, f, f, f}; }
}

__device__ __forceinline__ void ml1_job(const Params& p, int l, int job, unsigned char* lds, int tid, int lane, int wave) {
    const int b = job >> 7, h = (job >> 5) & 3, c = job & 31, tok0 = b * SEQ + c * 128;
    const bf16_t* zn = (const bf16_t*)(p.ws + WS_ZN); const bf16_t* ZT = (const bf16_t*)(p.ws + WS_ZT);
    const float* GB = (const float*)(p.ws + WS_GB); float* JS = (float*)(p.ws + WS_JS); bf16_t* DC = (bf16_t*)(p.ws + WS_DC);
    unsigned char* VT = lds; unsigned char* KT = lds + 272 * PB; float* wsm = (float*)(lds + 272 * PB + 128 * PB);
    load_vt(VT, ZT, h * 256, tok0, tid);
    const float* cwp = p.in[5] + (size_t)l * 4 * 1024; const float* cbp = p.in[6] + (size_t)l * 1024;
    float cw[2][4][8], cb[2][8]; u32x4 rk[2][5];
#pragma unroll
    for (int it = 0; it < 2; ++it) {
        const int d0 = (wave * 2 + it) * 8, chn = 512 + h * 128 + d0, s = 2 * lane;
#pragma unroll
        for (int e = 0; e < 8; ++e) { cb[it][e] = cbp[chn + e];
#pragma unroll
            for (int j = 0; j < 4; ++j) cw[it][j][e] = cwp[j * 1024 + chn + e]; }
#pragma unroll
        for (int i = 0; i < 5; ++i) { const int pos = c * 128 + s - 3 + i; rk[it][i] = (pos >= 0) ? *(const u32x4*)(zn + (size_t)(b * SEQ + pos) * ZN + chn) : (u32x4){0u, 0u, 0u, 0u}; }
    }
    if (wave == 0) {
        const float* g0p = GB + (size_t)(tok0 + 2 * lane) * 8;
        const float i0 = g0p[h], i1 = g0p[8 + h], f0 = g0p[4 + h], f1 = g0p[12 + h];
        const float incl = scan_sum(f0 + f1, lane), b1 = incl, b0 = incl - f1, bL = __shfl(incl, 63);
        const float g0 = bL - b0 + i0, g1 = bL - b1 + i1, mloc = wave_max(fmaxf(g0, g1));
        wsm[2 * lane] = __expf(g0 - mloc); wsm[2 * lane + 1] = __expf(g1 - mloc);
        if (lane == 0) { JS[job * 2] = mloc; JS[job * 2 + 1] = bL; }
    }
    __syncthreads();
#pragma unroll
    for (int it = 0; it < 2; ++it) {
        const int d0 = (wave * 2 + it) * 8, s = 2 * lane;
        float k0[8], k1[8]; conv8(rk[it], 0, cw[it], cb[it], k0); conv8(rk[it], 1, cw[it], cb[it], k1);
        const float w0 = wsm[s], w1 = wsm[s + 1];
#pragma unroll
        for (int e = 0; e < 8; ++e) *(unsigned*)(KT + (d0 + e) * PB + lane * 4) = cvt_pk_bf16(k0[e] * w0, k1[e] * w1);
    }
    __syncthreads();
    f32x4 acc[17];
#pragma unroll
    for (int i = 0; i < 17; ++i) acc[i] = (f32x4){0.f, 0.f, 0.f, 0.f};
#pragma unroll
    for (int ks = 0; ks < 4; ++ks) { const bf16x8 xk = ldfrag(KT, wave * 16, ks, lane);
#pragma unroll
        for (int mt = 0; mt < 17; ++mt) acc[mt] = __builtin_amdgcn_mfma_f32_16x16x32_bf16(xk, ldfrag(VT, mt * 16, ks, lane), acc[mt], 0, 0, 0); }
    bf16_t* o = DC + (size_t)job * DCJ + wave * 16 + 4 * (lane >> 4);
#pragma unroll
    for (int mp = 0; mp < 8; ++mp) { u32x2 a, b; a.x = cvt_pk_bf16(acc[2 * mp][0], acc[2 * mp][1]); a.y = cvt_pk_bf16(acc[2 * mp][2], acc[2 * mp][3]); b.x = cvt_pk_bf16(acc[2 * mp + 1][0], acc[2 * mp + 1][1]); b.y = cvt_pk_bf16(acc[2 * mp + 1][2], acc[2 * mp + 1][3]);
        const bool odd = ((lane >> 4) & 1) != 0;
        *(u32x4*)(o + ((2 * mp + (odd ? 1 : 0)) * 16 + (lane & 15)) * 128 - (odd ? 4 : 0)) = t21_pair(a, b, odd); }
    if ((lane & 15) == 0) { u32x2 w; w.x = cvt_pk_bf16(acc[16][0], acc[16][1]); w.y = cvt_pk_bf16(acc[16][2], acc[16][3]); *(u32x2*)(o + 256 * 128) = w; }
    __syncthreads();
}

__device__ __forceinline__ void ml2_scan(const Params& p, int gtid, int gthreads) {
    bf16_t* DC = (bf16_t*)(p.ws + WS_DC); const float* JS = (const float*)(p.ws + WS_JS); float* MS = (float*)(p.ws + WS_JS) + 1024;
    constexpr int E8 = DCJ / 8;
    for (int item = gtid; item < 16 * E8; item += gthreads) {
        const int bh = item / E8, e8 = item - bh * E8;
        float m = 0.f; float C[8];
#pragma unroll
        for (int e = 0; e < 8; ++e) C[e] = 0.f;
#pragma unroll 1
        for (int half = 0; half < 2; ++half) {
            u32x4 dv[16];
#pragma unroll
            for (int i = 0; i < 16; ++i) dv[i] = *(const u32x4*)(DC + (size_t)(bh * 32 + half * 16 + i) * DCJ + e8 * 8);
#pragma unroll
            for (int i = 0; i < 16; ++i) {
                const int job = bh * 32 + half * 16 + i; bf16_t* a = DC + (size_t)job * DCJ + e8 * 8;
                { u32x4 w; w.x = cvt_pk_bf16(C[0], C[1]); w.y = cvt_pk_bf16(C[2], C[3]); w.z = cvt_pk_bf16(C[4], C[5]); w.w = cvt_pk_bf16(C[6], C[7]); *(u32x4*)a = w; }
                const float mloc = JS[job * 2], bL = JS[job * 2 + 1];
                if (e8 == 0) MS[job] = m;
                const float mn = fmaxf(bL + m, mloc), al = __expf(bL + m - mn), be = __expf(mloc - mn);
                const unsigned dw[4] = {dv[i].x, dv[i].y, dv[i].z, dv[i].w};
#pragma unroll
                for (int e = 0; e < 4; ++e) { C[2 * e] = C[2 * e] * al + bflo(dw[e]) * be; C[2 * e + 1] = C[2 * e + 1] * al + bfhi(dw[e]) * be; }
                m = mn;
            }
        }
    }
}

__device__ __forceinline__ void ml3_job(const Params& p, int l, int job, unsigned char* lds, int tid, int lane, int wave) {
    const int b = job >> 7, h = (job >> 5) & 3, c = job & 31, tok0 = b * SEQ + c * 128;
    const bf16_t* zn = (const bf16_t*)(p.ws + WS_ZN); const bf16_t* ZT = (const bf16_t*)(p.ws + WS_ZT);
    const float* GB = (const float*)(p.ws + WS_GB); const float* MS = (const float*)(p.ws + WS_JS) + 1024; const bf16_t* DC = (const bf16_t*)(p.ws + WS_DC);
    bf16_t* hcat = (bf16_t*)(p.ws + WS_Y);
    unsigned char* Q = lds; unsigned char* KW = lds + 128 * PB; unsigned char* VC = lds + 256 * PB;
    float* aS = (float*)(lds + 528 * PB); float* Mx = aS + 128; float* bS = aS + 256;
    const float mc = MS[job];
    if (wave == 0) {
        const float* g0p = GB + (size_t)(tok0 + 2 * lane) * 8;
        const float i0 = g0p[h], i1 = g0p[8 + h], f0 = g0p[4 + h], f1 = g0p[12 + h];
        const float incl = scan_sum(f0 + f1, lane), b1 = incl, b0 = incl - f1;
        const float a0 = i0 - b0, a1 = i1 - b1;
        const float pin = scan_max(fmaxf(a0, a1), lane); float pex = __shfl_up(pin, 1); if (lane == 0) pex = -3.0e38f;
        const float p0 = fmaxf(pex, a0), p1 = pin;
        aS[2 * lane] = a0; aS[2 * lane + 1] = a1; bS[2 * lane] = b0; bS[2 * lane + 1] = b1;
        Mx[2 * lane] = fmaxf(mc, p0); Mx[2 * lane + 1] = fmaxf(mc, p1);
    }
    u32x4 cv[9];
    { const bf16_t* cs = DC + (size_t)job * DCJ;
#pragma unroll
      for (int i = 0; i < 9; ++i) { const int q = tid + 512 * i, v = q >> 4, ch = q & 15; cv[i] = (v < 257) ? *(const u32x4*)(cs + v * 128 + ch * 8) : (u32x4){0u, 0u, 0u, 0u}; } }
    const float* cwp = p.in[5] + (size_t)l * 4 * 1024; const float* cbp = p.in[6] + (size_t)l * 1024;
#pragma unroll 1
    for (int qk = 0; qk < 2; ++qk) {
        const int dch = tid & 15, tb = tid >> 4, chn = qk * 512 + h * 128 + dch * 8;
        float cw[4][8], cb[8];
#pragma unroll
        for (int e = 0; e < 8; e += 4) { const f32x4 b4 = *(const f32x4*)(cbp + chn + e); cb[e] = b4[0]; cb[e + 1] = b4[1]; cb[e + 2] = b4[2]; cb[e + 3] = b4[3];
#pragma unroll
            for (int j = 0; j < 4; ++j) { const f32x4 w4 = *(const f32x4*)(cwp + j * 1024 + chn + e); cw[j][e] = w4[0]; cw[j][e + 1] = w4[1]; cw[j][e + 2] = w4[2]; cw[j][e + 3] = w4[3]; } }
        u32x4 rr[4][4];
#pragma unroll
        for (int i = 0; i < 4; ++i)
#pragma unroll
            for (int j = 0; j < 4; ++j) { const int sp = c * 128 + tb + 32 * i - 3 + j; rr[i][j] = (sp >= 0) ? *(const u32x4*)(zn + (size_t)(b * SEQ + sp) * ZN + chn) : (u32x4){0u, 0u, 0u, 0u}; }
        const float sc = qk ? 1.0f : 0.08838834764831845f;
#pragma unroll
        for (int i = 0; i < 4; ++i) {
            const u32x4 r5[5] = {rr[i][0], rr[i][1], rr[i][2], rr[i][3], rr[i][3]};
            float o[8]; conv8(r5, 0, cw, cb, o);
            u32x4 w; w.x = cvt_pk_bf16(o[0] * sc, o[1] * sc); w.y = cvt_pk_bf16(o[2] * sc, o[3] * sc); w.z = cvt_pk_bf16(o[4] * sc, o[5] * sc); w.w = cvt_pk_bf16(o[6] * sc, o[7] * sc);
            *(u32x4*)((qk ? KW : Q) + (tb + 32 * i) * PB + dch * 16) = w;
        }
    }
#pragma unroll
    for (int i = 0; i < 9; ++i) { const int q = tid + 512 * i, v = q >> 4, ch = q & 15; if (v < 272) *(u32x4*)(VC + v * PB + ch * 16) = cv[i]; }
    __syncthreads();
    const int t0 = wave * 16, tl = t0 + (lane & 15), fq = lane >> 4;
    u32x4 vtr[8];
#pragma unroll
    for (int i = 0; i < 8; ++i) { const int q = tid + 512 * i, v = q >> 4, ch = q & 15; vtr[i] = *(const u32x4*)(ZT + (size_t)(h * 256 + v) * NTOK + tok0 + ch * 8); }
    bf16x8 qf[4];
#pragma unroll
    for (int ks = 0; ks < 4; ++ks) qf[ks] = ldfrag(Q, t0, ks, lane);
    f32x4 sacc[8];
#pragma unroll
    for (int st = 0; st < 8; ++st) { sacc[st] = (f32x4){0.f, 0.f, 0.f, 0.f};
        if (st <= wave) {
#pragma unroll
            for (int ks = 0; ks < 4; ++ks) sacc[st] = __builtin_amdgcn_mfma_f32_16x16x32_bf16(ldfrag(KW, st * 16, ks, lane), qf[ks], sacc[st], 0, 0, 0); } }
    f32x4 acc[17];
#pragma unroll
    for (int i = 0; i < 17; ++i) acc[i] = (f32x4){0.f, 0.f, 0.f, 0.f};
#pragma unroll
    for (int ks = 0; ks < 4; ++ks)
#pragma unroll
        for (int vt = 0; vt < 17; ++vt) acc[vt] = __builtin_amdgcn_mfma_f32_16x16x32_bf16(ldfrag(VC, vt * 16, ks, lane), qf[ks], acc[vt], 0, 0, 0);
    const float mxt = Mx[tl], bt = bS[tl];
#pragma unroll
    for (int st = 0; st < 8; ++st)
        if (st <= wave) {
            const f32x4 av = *(const f32x4*)(aS + st * 16 + 4 * fq);
#pragma unroll
            for (int r = 0; r < 4; ++r) { const int s = st * 16 + 4 * fq + r; sacc[st][r] = (s <= tl) ? __expf(av[r] - mxt) * sacc[st][r] : 0.f; }
        }
    __syncthreads();
#pragma unroll
    for (int st = 0; st < 8; ++st)
        if (st <= (wave | 1)) { u32x2 w; w.x = cvt_pk_bf16(sacc[st][0], sacc[st][1]); w.y = cvt_pk_bf16(sacc[st][2], sacc[st][3]); *(u32x2*)(KW + tl * PB + (st * 16 + 4 * fq) * 2) = w; }
#pragma unroll
    for (int i = 0; i < 8; ++i) { const int q = tid + 512 * i, v = q >> 4, ch = q & 15; *(u32x4*)(VC + v * PB + ch * 16) = vtr[i]; }
    if (tid < 256) { const int v = 256 + (tid >> 4), ch = tid & 15; const unsigned f = (v == 256) ? 0x3F803F80u : 0u; *(u32x4*)(VC + v * PB + ch * 16) = (u32x4){f, f, f, f}; }
    __syncthreads();
    const float sint = __expf(mc - mxt);
    const float* mg = p.in[9] + (size_t)l * 1024 + h * 256;
    const bf16_t* orow = zn + (size_t)(tok0 + tl) * ZN + 1024 + h * 256;
    f32x4 gva[16]; u32x2 owa[16];
#pragma unroll
    for (int vt = 0; vt < 16; ++vt) { const int v = vt * 16 + 4 * fq; gva[vt] = *(const f32x4*)(mg + v); owa[vt] = *(const u32x2*)(orow + v); }
#pragma unroll
    for (int vt = 0; vt < 17; ++vt) acc[vt] *= sint;
#pragma unroll
    for (int ks = 0; ks < 4; ++ks)
        if (ks <= (wave >> 1)) { const bf16x8 wf = ldfrag(KW, t0, ks, lane);
#pragma unroll
            for (int vt = 0; vt < 17; ++vt) acc[vt] = __builtin_amdgcn_mfma_f32_16x16x32_bf16(ldfrag(VC, vt * 16, ks, lane), wf, acc[vt], 0, 0, 0); }
    const float den = __shfl(acc[16][0], lane & 15);
    const float inv = 1.0f / fmaxf(fabsf(den), __expf(-(bt + mxt)));
    float s1 = 0.f;
#pragma unroll
    for (int vt = 0; vt < 16; ++vt) { acc[vt] *= inv; s1 += (acc[vt][0] + acc[vt][1]) + (acc[vt][2] + acc[vt][3]); }
    s1 += __shfl_xor(s1, 16); s1 += __shfl_xor(s1, 32);
    const float mu = s1 * (1.0f / 256.0f); float s2 = 0.f;
#pragma unroll
    for (int vt = 0; vt < 16; ++vt) { acc[vt] -= mu; s2 += (acc[vt][0] * acc[vt][0] + acc[vt][1] * acc[vt][1]) + (acc[vt][2] * acc[vt][2] + acc[vt][3] * acc[vt][3]); }
    s2 += __shfl_xor(s2, 16); s2 += __shfl_xor(s2, 32);
    const float rstd = rsqrtf(s2 * (1.0f / 256.0f) + EPS);
    bf16_t* hrow = hcat + (size_t)(tok0 + tl) * HC + h * 256;
#pragma unroll
    for (int vp = 0; vp < 8; ++vp) { u32x2 pc[2];
#pragma unroll
        for (int h2 = 0; h2 < 2; ++h2) { const int vt = 2 * vp + h2; const f32x4 gv = gva[vt]; const u32x2 ow = owa[vt];
            const float o0 = bflo(ow.x) * acc[vt][0] * rstd * gv[0], o1 = bfhi(ow.x) * acc[vt][1] * rstd * gv[1], o2 = bflo(ow.y) * acc[vt][2] * rstd * gv[2], o3 = bfhi(ow.y) * acc[vt][3] * rstd * gv[3];
            pc[h2].x = cvt_pk_bf16(o0, o1); pc[h2].y = cvt_pk_bf16(o2, o3); }
        const bool odd = (fq & 1) != 0;
        *(u32x4*)(hrow + 32 * vp + (odd ? 16 + 4 * (fq - 1) : 4 * fq)) = t21_pair(pc[0], pc[1], odd); }
    __syncthreads();
}

__device__ __forceinline__ void gmlp_job(const Params& p, int l, int job, unsigned char* lds, int tid, int lane, int wave) {
    const int g = job & 3, bc = job >> 2, tok0 = bc * 128;
    const bf16_t* zn = (const bf16_t*)(p.ws + WS_ZN); const bf16_t* ZT = (const bf16_t*)(p.ws + WS_ZT);
    bf16_t* hcat = (bf16_t*)(p.ws + WS_Y);
    unsigned char* WM = lds; unsigned char* VN = lds + 128 * PB;
    float* mu = (float*)(lds + 384 * PB); float* rs = mu + 128;
    u32x4 vw[8]; float gaa[8], bea[8];
    { const float* gam = p.in[10] + (size_t)l * 1024 + g * 256; const float* bet = p.in[11] + (size_t)l * 1024 + g * 256;
#pragma unroll
      for (int i = 0; i < 8; ++i) { const int q = tid + 512 * i, d = q >> 4, ch = q & 15; vw[i] = *(const u32x4*)(ZT + (size_t)(1024 + g * 256 + d) * NTOK + tok0 + ch * 8); gaa[i] = gam[d]; bea[i] = bet[d]; } }
    if (tid < 128) { const float* SP = (const float*)(p.ws + WS_SP) + tok0 + tid; float sm = 0.f, sq = 0.f;
#pragma unroll
        for (int i = 0; i < 8; ++i) { sm += SP[(size_t)i * NTOK]; sq += SP[(size_t)(8 + i) * NTOK]; }
        const float m = sm * (1.0f / 1024.0f), var = fmaxf(sq * (1.0f / 1024.0f) - m * m, 0.f);
        mu[tid] = m; rs[tid] = rsqrtf(var + EPS); }
    {
        const float* wsp = p.in[12] + ((size_t)l * 4 + g) * 128 * 128;
#pragma unroll
        for (int i = 0; i < 4; ++i) { const int q = tid + 512 * i, t = q >> 4, ch = q & 15; const f32x4 x0 = *(const f32x4*)(wsp + t * 128 + ch * 8), x1 = *(const f32x4*)(wsp + t * 128 + ch * 8 + 4);
            float o[8] = {x0[0], x0[1], x0[2], x0[3], x1[0], x1[1], x1[2], x1[3]};
#pragma unroll
            for (int e = 0; e < 8; ++e) if (ch * 8 + e > t) o[e] = 0.f;
            u32x4 w; w.x = cvt_pk_bf16(o[0], o[1]); w.y = cvt_pk_bf16(o[2], o[3]); w.z = cvt_pk_bf16(o[4], o[5]); w.w = cvt_pk_bf16(o[6], o[7]);
            *(u32x4*)(WM + t * PB + ch * 16) = w; }
    }
    __syncthreads();
    {
#pragma unroll
        for (int i = 0; i < 8; ++i) { const int q = tid + 512 * i, d = q >> 4, ch = q & 15;
            const u32x4 w = vw[i];
            const unsigned ww[4] = {w.x, w.y, w.z, w.w}; const float ga = gaa[i], be = bea[i];
            const f32x4 m0 = *(const f32x4*)(mu + ch * 8), m1 = *(const f32x4*)(mu + ch * 8 + 4), r0 = *(const f32x4*)(rs + ch * 8), r1 = *(const f32x4*)(rs + ch * 8 + 4);
            const float mm[8] = {m0[0], m0[1], m0[2], m0[3], m1[0], m1[1], m1[2], m1[3]}, rr[8] = {r0[0], r0[1], r0[2], r0[3], r1[0], r1[1], r1[2], r1[3]};
            float o[8];
#pragma unroll
            for (int e = 0; e < 4; ++e) { o[2 * e] = (bflo(ww[e]) - mm[2 * e]) * rr[2 * e] * ga + be; o[2 * e + 1] = (bfhi(ww[e]) - mm[2 * e + 1]) * rr[2 * e + 1] * ga + be; }
            u32x4 wo; wo.x = cvt_pk_bf16(o[0], o[1]); wo.y = cvt_pk_bf16(o[2], o[3]); wo.z = cvt_pk_bf16(o[4], o[5]); wo.w = cvt_pk_bf16(o[6], o[7]);
            *(u32x4*)(VN + d * PB + ch * 16) = wo; }
    }
    __syncthreads();
    const int t0 = wave * 16, tl = t0 + (lane & 15), fq = lane >> 4;
    const bf16_t* urow = zn + (size_t)(tok0 + tl) * ZN + 2048 + g * 256;
    u32x2 uwa[16];
#pragma unroll
    for (int dt = 0; dt < 16; ++dt) uwa[dt] = *(const u32x2*)(urow + dt * 16 + 4 * fq);
    f32x4 acc[16];
#pragma unroll
    for (int i = 0; i < 16; ++i) acc[i] = (f32x4){0.f, 0.f, 0.f, 0.f};
#pragma unroll
    for (int ks = 0; ks < 4; ++ks)
        if (ks <= (wave >> 1)) { const bf16x8 wf = ldfrag(WM, t0, ks, lane);
#pragma unroll
            for (int dt = 0; dt < 16; ++dt) acc[dt] = __builtin_amdgcn_mfma_f32_16x16x32_bf16(ldfrag(VN, dt * 16, ks, lane), wf, acc[dt], 0, 0, 0); }
    const float bs = p.in[13][((size_t)l * 4 + g) * 128 + tl];
    bf16_t* hrow = hcat + (size_t)(tok0 + tl) * HC + 1024 + g * 256;
#pragma unroll
    for (int dp = 0; dp < 8; ++dp) { u32x2 pc[2];
#pragma unroll
        for (int h2 = 0; h2 < 2; ++h2) { const int dt = 2 * dp + h2; const u32x2 uw = uwa[dt];
            pc[h2].x = cvt_pk_bf16(bflo(uw.x) * (acc[dt][0] + bs), bfhi(uw.x) * (acc[dt][1] + bs)); pc[h2].y = cvt_pk_bf16(bflo(uw.y) * (acc[dt][2] + bs), bfhi(uw.y) * (acc[dt][3] + bs)); }
        const bool odd = (fq & 1) != 0;
        *(u32x4*)(hrow + 32 * dp + (odd ? 16 + 4 * (fq - 1) : 4 * fq)) = t21_pair(pc[0], pc[1], odd); }
    __syncthreads();
}


#define RLX_AGENT __ATOMIC_RELAXED, __HIP_MEMORY_SCOPE_AGENT
#define XB_TMO      128
#define XB_XCNT(j)  (256  + 64 * (j))
#define XB_XSUB(j)  (1280 + 64 * (j))
#define XB_XGEN(j)  (2304 + 64 * (j))
#define XB_TOP      3328
#define XB_TOPGEN   3392
#define XCD_BAR_WORDS 3456
#define XB_SPIN_CAP (1u << 18)

__device__ __forceinline__ unsigned xb_ld(unsigned* p)              { return __hip_atomic_load(p, __ATOMIC_RELAXED, __HIP_MEMORY_SCOPE_AGENT); }
__device__ __forceinline__ unsigned xb_add(unsigned* p, unsigned v) { return __hip_atomic_fetch_add(p, v, __ATOMIC_RELAXED, __HIP_MEMORY_SCOPE_AGENT); }
__device__ __forceinline__ unsigned xb_xcc_id() { return (unsigned)__builtin_amdgcn_s_getreg((3 << 11) | 20) & 0xFu; }
#define XB_SPIN(cond, bar) do { unsigned _sp = 0; while (cond) { __builtin_amdgcn_s_sleep(1); \
    if ((++_sp & 255u) == 0u) { if (xb_ld(&(bar)[XB_TMO])) break; if (_sp > XB_SPIN_CAP) { atomicAdd(&(bar)[XB_TMO], 1u); break; } } } } while (0)

struct XcdBarrier {
    unsigned* bar; unsigned x;
    volatile LAS unsigned* st;
};

__device__ __forceinline__ XcdBarrier xcd_barrier_post(unsigned* bar, volatile LAS unsigned* st) {
    XcdBarrier b; b.bar = bar; b.x = xb_xcc_id(); b.st = st;
    if (threadIdx.x == 0) (void)xb_add(&bar[XB_XCNT(b.x)], 1u);
    return b;
}
__device__ __forceinline__ void xcd_barrier_complete(unsigned* bar, unsigned x, unsigned& nloc, unsigned& nx) {
    const unsigned G = gridDim.x * gridDim.y * gridDim.z;
    unsigned sum, cnt, mine, sp = 0u;
    for (;;) {
        sum = 0u; cnt = 0u; mine = 0u;
#pragma unroll
        for (unsigned j = 0; j < 16; ++j) { const unsigned c = xb_ld(&bar[XB_XCNT(j)]); sum += c; cnt += (c > 0u) ? 1u : 0u; mine = (j == x) ? c : mine; }
        if (sum == G) break;
        __builtin_amdgcn_s_sleep(1);
        if ((++sp & 255u) == 0u) { if (xb_ld(&bar[XB_TMO])) break; if (sp > XB_SPIN_CAP) { atomicAdd(&bar[XB_TMO], 1u); break; } }
    }
    nloc = mine > 0u ? mine : 1u; nx = cnt > 0u ? cnt : 1u;
}

__device__ __forceinline__ void xcd_barrier(const XcdBarrier& b) {
    asm volatile("s_waitcnt vmcnt(0)" ::: "memory");
    __syncthreads();
    if (threadIdx.x == 0) {
        unsigned* bar = b.bar;
        __builtin_amdgcn_s_waitcnt(0);
        unsigned nloc = b.st[0], nx = b.st[1];
        if (nloc == 0u) { xcd_barrier_complete(bar, b.x, nloc, nx); b.st[0] = nloc; b.st[1] = nx; }
        const unsigned old = xb_add(&bar[XB_XSUB(b.x)], 1u);
        const unsigned gen = old / nloc;
        if (old + 1u == (gen + 1u) * nloc) {
            __builtin_amdgcn_fence(__ATOMIC_RELEASE, "agent");
            asm volatile("s_waitcnt vmcnt(0)" ::: "memory");
            const unsigned og = xb_add(&bar[XB_TOP], 1u);
            const unsigned tg = og / nx;
            if (og + 1u == (tg + 1u) * nx) xb_add(&bar[XB_TOPGEN], 1u);
            else XB_SPIN(xb_ld(&bar[XB_TOPGEN]) == tg, bar);
            __builtin_amdgcn_fence(__ATOMIC_ACQUIRE, "agent");
            xb_add(&bar[XB_XGEN(b.x)], 1u);
            asm volatile("s_waitcnt vmcnt(0)" ::: "memory");
        } else {
            XB_SPIN(xb_ld(&bar[XB_XGEN(b.x)]) == gen, bar);
            __builtin_amdgcn_fence(__ATOMIC_ACQUIRE, "agent");
            asm volatile("s_waitcnt vmcnt(0)" ::: "memory");
        }
    }
    __syncthreads();
}


#define LAYER_IDS() int lo = l; asm volatile("" : "+s"(lo)); const float* gains = p.in[1] + (size_t)lo * 6 * DM
#define PHASE_IDS() int G = G0, bx = bx0; asm volatile("" : "+s"(G), "+s"(bx)); const int NGW = G * NWAVES; (void)NGW; unsigned zz_ = 0u; asm volatile("" : "+v"(zz_)); const int lane = (int)__builtin_amdgcn_mbcnt_hi(~0u, __builtin_amdgcn_mbcnt_lo(~0u, zz_)), wave = wave_s; const int tid = wave * 64 + lane; const int gw = bx * NWAVES + wave; (void)lane; (void)gw
__global__ void __launch_bounds__(NTHREADS, 2) fwd_megakernel(Params p) {
    extern __shared__ __attribute__((aligned(16))) unsigned char lds[];
    cg::grid_group grid = cg::this_grid();
    const int G0 = gridDim.x, bx0 = blockIdx.x;
    const int wave_s = __builtin_amdgcn_readfirstlane((int)threadIdx.x >> 6);
    if (threadIdx.x < 4) ((volatile LAS unsigned*)((LAS unsigned char*)lds + BAR_LDS_OFF))[threadIdx.x] = 0u;
    __syncthreads();
    const XcdBarrier xbar = xcd_barrier_post((unsigned*)(p.ws + WS_BAR), (volatile LAS unsigned*)((LAS unsigned char*)lds + BAR_LDS_OFF));
    LAS unsigned char* ldsl = (LAS unsigned char*)lds;
    unsigned char* ws = p.ws;
    const float* RB = (const float*)(ws + WS_RB);
    bf16_t* XB = (bf16_t*)(ws + WS_XB); bf16_t* ZNp = (bf16_t*)(ws + WS_ZN); bf16_t* ZTp = (bf16_t*)(ws + WS_ZT); float* Y = (float*)(ws + WS_Y);
    bf16_t* HID = ZNp; bf16_t* HCAT = (bf16_t*)(ws + WS_Y); bf16_t* MRG = XB;

    { PHASE_IDS(); ew0_phase(p, p.in[0], gw, NGW, lane); convert_layer(p, 0, -1, lds, gw, NGW, lane, wave); }
    grid.sync();

    for (int l = 0; l < DEPTH; ++l) {
        for (int f = 0; f < 2; ++f) {
            if (bx0 >= G0 / 2) { PHASE_IDS(); LAYER_IDS(); (void)gains; const int hw = (bx - G / 2) * NWAVES + wave, HNW = (G - G / 2) * NWAVES;
              if (f == 0) convert_layer(p, -1, lo, lds, hw, HNW, lane, wave); else if (l + 1 < DEPTH) convert_layer(p, lo + 1, -1, lds, hw, HNW, lane, wave); }
            __syncthreads();
            { PHASE_IDS(); pg8::Gemm g{XB, (const bf16_t*)(ws + (f ? WS_W1B : WS_W1A)), NTOK, 2 * DFF, DM}; pg8::StaticOrder S; S.init(NTOK, 2 * DFF, G, bx);
              pg8::EpiSwiGLU E{HID, RB}; pg8::gemm_phase(ldsl, g, S, E, tid); }
            xcd_barrier(xbar);
            if (f == 0) { PHASE_IDS(); LAYER_IDS(); pg8::Gemm g{HID, (const bf16_t*)(ws + WS_W2A), NTOK, DM, DFF}; pg8::StaticOrder S; S.init(NTOK, DM, G, bx);
              pg8::EpiRes<true> E{(lo == 0) ? p.in[0] : (const float*)(ws + WS_XT), (float*)(ws + WS_XT), (lo == 0) ? 0 : 1, 1, XB, (float*)(ws + WS_RB), (float*)(ws + WS_GB), gains + 1 * DM, 0.5f, (const float*)(ws + WS_WG), p.in[7] + lo * 4, p.in[8] + lo * 4,
                                  (unsigned*)(ws + WS_XCH), (unsigned*)(ws + WS_XCH) + NTOK * 4, (unsigned*)(ws + WS_CNT) + (lo * 6 + 0) * 4096, (unsigned*)(ws + WS_CNT) + (lo * 6 + 1) * 4096};
              pg8::gemm_phase(ldsl, g, S, E, tid); }
            else { PHASE_IDS(); LAYER_IDS(); pg8::Gemm g{HID, (const bf16_t*)(ws + WS_W2B), NTOK, DM, DFF}; pg8::StaticOrder S; S.init(NTOK, DM, G, bx);
              pg8::EpiRes<false> E{(const float*)(ws + WS_XT), (l == DEPTH - 1) ? p.out : (float*)(ws + WS_XT), 1, (l == DEPTH - 1) ? 0 : 1, XB, (float*)(ws + WS_RB), nullptr, gains + 5 * DM, 0.5f, nullptr, nullptr, nullptr,
                                   (unsigned*)(ws + WS_XCH), (unsigned*)(ws + WS_XCH) + NTOK * 4, (unsigned*)(ws + WS_CNT) + (lo * 6 + 4) * 4096, (unsigned*)(ws + WS_CNT) + (lo * 6 + 5) * 4096};
              pg8::gemm_phase(ldsl, g, S, E, tid); }
            if (!(l == DEPTH - 1 && f == 1)) xcd_barrier(xbar);
            if (f == 0) {
                { PHASE_IDS(); pg8::Gemm g{XB, (const bf16_t*)(ws + WS_WIN), NTOK, ZN, DM}; pg8::StaticOrder S; S.init(NTOK, ZN, G, bx);
                  pg8::EpiZ E{ZNp, RB}; pg8::gemm_phase(ldsl, g, S, E, tid); }
                { PHASE_IDS(); pg8::Gemm g{(const bf16_t*)(ws + WS_WVT), XB, ZTR, NTOK, DM}; pg8::StaticOrder S; S.init(ZTR, NTOK, G, bx);
                  pg8::EpiZT E{ZTp, RB, (float*)(ws + WS_SP)}; pg8::gemm_phase(ldsl, g, S, E, tid); }
                xcd_barrier(xbar);
                for (int it = bx0; it < 1024; it += G0) { PHASE_IDS(); LAYER_IDS(); (void)gains; if (it < 512) ml1_job(p, lo, it, lds, tid, lane, wave); else gmlp_job(p, lo, it - 512, lds, tid, lane, wave); }
                xcd_barrier(xbar);
                { PHASE_IDS(); LAYER_IDS(); (void)gains; ml2_scan(p, bx * NTHREADS + tid, G * NTHREADS); }
                xcd_barrier(xbar);
                for (int it = bx0; it < 512; it += G0) { PHASE_IDS(); LAYER_IDS(); (void)gains; ml3_job(p, lo, it, lds, tid, lane, wave); }
                xcd_barrier(xbar);
                { PHASE_IDS(); pg8::Gemm g{HCAT, (const bf16_t*)(ws + WS_WP), NTOK, DM, 2 * DM}; pg8::StaticOrder S; S.init(NTOK, DM, G, bx);
                  pg8::EpiMerge E{MRG, ZNp}; pg8::gemm_phase(ldsl, g, S, E, tid); }
                xcd_barrier(xbar);
                { PHASE_IDS(); LAYER_IDS(); pg8::Gemm g{MRG, (const bf16_t*)(ws + WS_WO), NTOK, DM, DM}; pg8::StaticOrder S; S.init(NTOK, DM, G, bx);
                  pg8::EpiRes<false> E{(const float*)(ws + WS_XT), (float*)(ws + WS_XT), 1, 1, MRG, (float*)(ws + WS_RB), nullptr, gains + 3 * DM, 1.0f, nullptr, nullptr, nullptr,
                                       (unsigned*)(ws + WS_XCH), (unsigned*)(ws + WS_XCH) + NTOK * 4, (unsigned*)(ws + WS_CNT) + (lo * 6 + 2) * 4096, (unsigned*)(ws + WS_CNT) + (lo * 6 + 3) * 4096};
                  pg8::gemm_phase(ldsl, g, S, E, tid); }
                xcd_barrier(xbar);
            }
        }
    }
}

extern "C" void kernel_launch(void* const* d_in, const int* in_sizes, int n_in, void* d_out, int out_size, void* d_ws, size_t ws_size, hipStream_t stream) {
    static int grid_blocks = 0;
    if (!grid_blocks) {
        int dev = 0, cus = 0, per_cu = 0;
        hipGetDevice(&dev);
        hipDeviceGetAttribute(&cus, hipDeviceAttributeMultiprocessorCount, dev);
        hipFuncSetAttribute((const void*)fwd_megakernel, hipFuncAttributeMaxDynamicSharedMemorySize, LDS_BYTES);
        hipOccupancyMaxActiveBlocksPerMultiprocessor(&per_cu, (const void*)fwd_megakernel, NTHREADS, LDS_BYTES);
        if (per_cu < 1) per_cu = 1;
        grid_blocks = cus * 1;
        if (ws_size < WS_END) { fprintf(stderr, "kernel_launch: workspace too small (%zu < %zu)\n", ws_size, (size_t)WS_END); }
    }
    (void)hipMemsetAsync((char*)d_ws + WS_BAR, 0, 65536 + 24 * 4096 * 4, stream);
    Params p{};
    for (int i = 0; i < 19; ++i) p.in[i] = (const float*)d_in[i];
    p.out = (float*)d_out; p.ws = (unsigned char*)d_ws;
    void* args[] = {&p};
    hipError_t e = hipLaunchCooperativeKernel((const void*)fwd_megakernel, dim3(grid_blocks), dim3(NTHREADS), args, LDS_BYTES, stream);
    if (e != hipSuccess) fprintf(stderr, "cooperative launch failed: %s (grid %d)\n", hipGetErrorString(e), grid_blocks);
}
```

```cpp
#include <hip/hip_runtime.h>
#include <hip/hip_cooperative_groups.h>
#include <cstdio>
namespace cg = cooperative_groups;

#define LAS __attribute__((address_space(3)))
typedef unsigned short bf16_t;
typedef short bf16x8 __attribute__((ext_vector_type(8)));
typedef float f32x4 __attribute__((ext_vector_type(4)));
typedef float f32x2 __attribute__((ext_vector_type(2)));
typedef unsigned u32x4 __attribute__((ext_vector_type(4)));
typedef unsigned u32x2 __attribute__((ext_vector_type(2)));

constexpr int DM = 1024, NTOK = 16384, SEQ = 4096, DEPTH = 4;
constexpr int DFF = 2816, WIN_COLS = 7176;
constexpr int ZN = 5120;
constexpr int ZTR = 2048;
constexpr int HC = 2048;
constexpr int DCJ = 257 * 128;
constexpr float EPS = 1e-6f;
constexpr int NTHREADS = 512, NWAVES = 8;
constexpr int LDS_BYTES = 147456;

constexpr size_t MiB = 1u << 20;
constexpr size_t WS_W1A = 0, WS_W2A = 11 * MiB, WS_W1B = WS_W2A + 11 * MiB / 2, WS_W2B = WS_W1B + 11 * MiB,
                 WS_WIN = 33 * MiB, WS_WVT = 43 * MiB, WS_WP = 47 * MiB, WS_WO = 51 * MiB, WS_WG = 53 * MiB,
                 WS_RB = 54 * MiB, WS_GB = 54 * MiB + 512 * 1024, WS_JS = 55 * MiB,
                 WS_XB = 56 * MiB, WS_ZN = 88 * MiB, WS_ZT = 248 * MiB, WS_Y = 312 * MiB, WS_DC = 376 * MiB, WS_BAR = 409 * MiB, WS_CNT = 409 * MiB + 65536, WS_XCH = 410 * MiB, WS_SP = 414 * MiB, WS_XT = 415 * MiB, WS_END = 479 * MiB;
constexpr int BAR_LDS_OFF = LDS_BYTES - 16;

struct Params {
    const float* in[19];
    float* out;
    unsigned char* ws;
};

__device__ __forceinline__ unsigned cvt_pk_bf16(float lo, float hi) { unsigned r; asm volatile("v_cvt_pk_bf16_f32 %0, %1, %2" : "=v"(r) : "v"(lo), "v"(hi)); return r; }
__device__ __forceinline__ float bflo(unsigned w) { return __uint_as_float(w << 16); }
__device__ __forceinline__ float bfhi(unsigned w) { return __uint_as_float(w & 0xffff0000u); }
__device__ __forceinline__ float wave_sum(float v) {
#pragma unroll
    for (int o = 1; o < 64; o <<= 1) v += __shfl_xor(v, o);
    return v;
}
__device__ __forceinline__ float wave_max(float v) {
#pragma unroll
    for (int o = 1; o < 64; o <<= 1) v = fmaxf(v, __shfl_xor(v, o));
    return v;
}
__device__ __forceinline__ float fast_sigmoid(float x) { return __builtin_amdgcn_rcpf(1.0f + __expf(-x)); }
__device__ __forceinline__ float gelu_tanh(float x) { const float u = 0.7978845608028654f * (x + 0.044715f * x * x * x); return x * __builtin_amdgcn_rcpf(1.0f + __expf(-2.0f * u)); }
__device__ __forceinline__ float silu_f(float x) { return x * __builtin_amdgcn_rcpf(1.0f + __expf(-x)); }
#define LDS_WAIT() asm volatile("s_waitcnt lgkmcnt(0)" ::: "memory")

namespace pg8 {
constexpr int BM = 256, BK = 64, HALF = 128, HTB = HALF * BK * 2, STAGE_BYTES = 8 * HTB, NXCD = 8, WGM = 8;
__device__ __forceinline__ int lds_byte(int r, int c) { const int st = (r >> 4) * 2 + (c >> 5), rr = r & 15, cc = c & 31, ob = rr * 64 + cc * 2; return st * 1024 + (ob ^ (((ob >> 9) & 1) << 5)); }
__device__ __forceinline__ void stage_rc(int b, int& R, int& C) { const int st = b / 1024, sb = b % 1024, swz = sb ^ (((sb >> 9) & 1) << 5); R = (st >> 1) * 16 + swz / 64; C = (st & 1) * 32 + (swz % 64) / 2; }
__device__ __forceinline__ int perm32(int rho) { const int n = rho >> 4, i = rho & 15; return 8 * (i >> 2) + 4 * n + (i & 3); }
struct Unit { int pm, pn; };
struct Gemm { const bf16_t* A; const bf16_t* Bt; int M, N, K; };
struct StaticOrder {
    int nM, nN, nwg, G, c;
    __device__ void init(int M, int N, int G_, int c_) { nM = M / BM; nN = N / BM; nwg = nM * nN; G = G_; c = c_; }
    __device__ bool next(int i, Unit& u) const {
        const long L = (long)i * G + c; if (L >= nwg) return false;
        int wgid = (int)L; { const int q = nwg / NXCD, r = nwg % NXCD, xcd = wgid % NXCD, off = wgid / NXCD; wgid = (xcd < r ? xcd * (q + 1) : r * (q + 1) + (xcd - r) * q) + off; }
        const int nig = WGM * nN, gid = wgid / nig, fm = gid * WGM, gsz = (nM - fm) < WGM ? (nM - fm) : WGM;
        u.pm = fm + ((wgid % nig) % gsz); u.pn = (wgid % nig) / gsz; return true;
    }
};

template <class Epi>
__device__ __forceinline__ void gemm_phase(LAS unsigned char* lds, const Gemm g, const StaticOrder& S, const Epi& E, const int tid) {
    const int wid = __builtin_amdgcn_readfirstlane(tid >> 6), lane = tid & 63, wr = wid >> 2, wc = wid & 3, fr = lane & 15, fq = lane >> 4;
    const int K = g.K, nt = K / BK;
    unsigned voffA[2], voffB[2];
#pragma unroll
    for (int i = 0; i < 2; ++i) { int R, C; stage_rc(tid * 16 + i * 8192, R, C); const int Rb = Epi::PERM ? ((R & ~31) + perm32(R & 31)) : R;
        voffA[i] = (unsigned)(R * K + C) * 2u; voffB[i] = (unsigned)(Rb * K + C) * 2u; }
    const size_t kstep = (size_t)(BK * 2);
    const size_t hstep = (size_t)HALF * K * 2;
    const size_t tstep = 2 * hstep;
    const unsigned ldsw = (unsigned)wid * 1024u;
    const int aoff = lds_byte(wr * 64 + fr, fq * 8), boff = lds_byte(wc * 32 + fr, fq * 8);
#define PG8_SA(b, h) (((b) * 2 + (h)) * HTB)
#define PG8_SB(b, h) ((4 + (b) * 2 + (h)) * HTB)
#define PG8_STAGE(bufoff, gbase, voff) do { _Pragma("unroll") for (int _i = 0; _i < 2; ++_i) \
        __builtin_amdgcn_global_load_lds((const unsigned*)((const char*)(gbase) + (voff)[_i]), (LAS unsigned*)(lds + (bufoff) + ldsw + _i * 8192), 16, 0, 0); } while (0)
#define PG8_LDA(dst, b, h) do { _Pragma("unroll") for (int m = 0; m < 4; ++m) _Pragma("unroll") for (int k = 0; k < 2; ++k) dst[m][k] = *(const LAS bf16x8*)(lds + PG8_SA(b, h) + aoff + m * 2048 + k * 1024); } while (0)
#define PG8_LDB(dst, b, h) do { _Pragma("unroll") for (int n = 0; n < 2; ++n) _Pragma("unroll") for (int k = 0; k < 2; ++k) dst[n][k] = *(const LAS bf16x8*)(lds + PG8_SB(b, h) + boff + n * 2048 + k * 1024); } while (0)
#define PG8_MMA(ai, bj, At, Bt) do { __builtin_amdgcn_s_setprio(1); _Pragma("unroll") for (int m = 0; m < 4; ++m) _Pragma("unroll") for (int n = 0; n < 2; ++n) _Pragma("unroll") for (int k = 0; k < 2; ++k) \
        acc[ai][bj][m][n] = __builtin_amdgcn_mfma_f32_16x16x32_bf16(Bt[n][k], At[m][k], acc[ai][bj][m][n], 0, 0, 0); __builtin_amdgcn_s_setprio(0); } while (0)
#define PG8_WAIT_V(n) asm volatile("s_waitcnt vmcnt(" #n ")" ::: "memory")
#define PG8_WAIT_L(n) asm volatile("s_waitcnt lgkmcnt(" #n ")" ::: "memory")
#define PG8_BAR __builtin_amdgcn_s_barrier()
#define PG8_SCHED __builtin_amdgcn_sched_barrier(0)
    Unit cur, nxt; int ui = 0;
    if (!S.next(0, cur)) return;
    f32x4 acc[2][2][4][2];
#pragma unroll
    for (int a = 0; a < 2; ++a)
#pragma unroll
        for (int b = 0; b < 2; ++b)
#pragma unroll
            for (int m = 0; m < 4; ++m)
#pragma unroll
                for (int n = 0; n < 2; ++n) acc[a][b][m][n] = (f32x4){0.f, 0.f, 0.f, 0.f};
    bf16x8 At[4][2], B0[2][2], B1[2][2];
    const char* cA = (const char*)g.A + (size_t)cur.pm * tstep; const char* cB = (const char*)g.Bt + (size_t)cur.pn * tstep;
    PG8_STAGE(PG8_SB(0, 0), cB, voffB); PG8_STAGE(PG8_SA(0, 0), cA, voffA); PG8_STAGE(PG8_SB(0, 1), cB + hstep, voffB); PG8_STAGE(PG8_SA(0, 1), cA + hstep, voffA);
    if (wr == 1) PG8_BAR;
    PG8_WAIT_V(4); PG8_BAR;
    PG8_STAGE(PG8_SB(1, 0), cB + kstep, voffB); PG8_STAGE(PG8_SA(1, 0), cA + kstep, voffA); PG8_STAGE(PG8_SB(1, 1), cB + hstep + kstep, voffB);
    PG8_WAIT_V(6); PG8_BAR;
    for (;;) {
        const bool has_next = S.next(ui + 1, nxt);
        const char* nA = has_next ? (const char*)g.A + (size_t)nxt.pm * tstep : cA; const char* nB = has_next ? (const char*)g.Bt + (size_t)nxt.pn * tstep : cB;
        for (int t = 0; t < nt; t += 2) {
            const bool last = (t == nt - 2);
            const char* a1 = cA + (size_t)(t + 1) * kstep;
            const char* a2 = last ? nA : cA + (size_t)(t + 2) * kstep; const char* b2 = last ? nB : cB + (size_t)(t + 2) * kstep;
            const char* a3 = a2 + kstep; const char* b3 = b2 + kstep;
            if constexpr (Epi::HAS_MID) { if (t == nt / 2) E.mid(acc, cur, wr, wc, fr, fq); }
            PG8_LDB(B0, 0, 0); PG8_SCHED; PG8_LDA(At, 0, 0); PG8_STAGE(PG8_SA(1, 1), a1 + hstep, voffA);
            PG8_WAIT_L(8); PG8_BAR; PG8_WAIT_L(0); PG8_MMA(0, 0, At, B0); PG8_BAR; PG8_SCHED;
            PG8_LDB(B1, 0, 1); PG8_STAGE(PG8_SB(0, 0), b2, voffB);
            PG8_BAR; PG8_WAIT_L(0); PG8_MMA(0, 1, At, B1); PG8_BAR;
            PG8_LDA(At, 0, 1); PG8_STAGE(PG8_SA(0, 0), a2, voffA);
            PG8_BAR; PG8_WAIT_L(0); PG8_MMA(1, 0, At, B0); PG8_BAR; PG8_SCHED;
            PG8_STAGE(PG8_SB(0, 1), b2 + hstep, voffB);
            PG8_WAIT_V(6); PG8_BAR; PG8_MMA(1, 1, At, B1); PG8_BAR;
            PG8_LDB(B0, 1, 0); PG8_SCHED; PG8_LDA(At, 1, 0); PG8_STAGE(PG8_SA(0, 1), a2 + hstep, voffA);
            PG8_WAIT_L(8); PG8_BAR; PG8_WAIT_L(0); PG8_MMA(0, 0, At, B0); PG8_BAR; PG8_SCHED;
            PG8_LDB(B1, 1, 1); PG8_STAGE(PG8_SB(1, 0), b3, voffB);
            PG8_BAR; PG8_WAIT_L(0); PG8_MMA(0, 1, At, B1); PG8_BAR;
            PG8_LDA(At, 1, 1); PG8_STAGE(PG8_SA(1, 0), a3, voffA);
            PG8_BAR; PG8_WAIT_L(0); PG8_MMA(1, 0, At, B0); PG8_BAR; PG8_SCHED;
            PG8_STAGE(PG8_SB(1, 1), b3 + hstep, voffB);
            PG8_WAIT_V(6); PG8_BAR; PG8_MMA(1, 1, At, B1); PG8_BAR;
        }
        if constexpr (!Epi::AFTER_DRAIN) E(acc, cur, wr, wc, fr, fq);
        if (!has_next) break;
#pragma unroll
        for (int a = 0; a < 2; ++a)
#pragma unroll
            for (int b = 0; b < 2; ++b)
#pragma unroll
                for (int m = 0; m < 4; ++m)
#pragma unroll
                    for (int n = 0; n < 2; ++n) acc[a][b][m][n] = (f32x4){0.f, 0.f, 0.f, 0.f};
        cur = nxt; cA = nA; cB = nB; ++ui;
    }
    PG8_WAIT_V(0);
    if (wr == 0) PG8_BAR;
    PG8_BAR;
    if constexpr (Epi::AFTER_DRAIN) E.fused(acc, cur, wr, wc, fr, fq, lds, tid, wid, lane);
#undef PG8_SA
#undef PG8_SB
#undef PG8_STAGE
#undef PG8_LDA
#undef PG8_LDB
#undef PG8_MMA
#undef PG8_WAIT_V
#undef PG8_WAIT_L
#undef PG8_BAR
#undef PG8_SCHED
}

struct EpiSwiGLU {
    static constexpr bool PERM = true, HAS_MID = false, AFTER_DRAIN = false;
    bf16_t* O; const float* rs;
    __device__ __forceinline__ void mid(f32x4 (&)[2][2][4][2], const Unit&, int, int, int, int) const {}
    __device__ __forceinline__ void operator()(const f32x4 (&acc)[2][2][4][2], const Unit& u, int wr, int wc, int fr, int fq) const {
        const int row0 = u.pm * BM + wr * 64 + fr, col0 = u.pn * 128 + wc * 32 + 8 * fq;
#pragma unroll
        for (int ai = 0; ai < 2; ++ai)
#pragma unroll
            for (int m = 0; m < 4; ++m) {
                const int row = row0 + ai * HALF + m * 16;
                float o[8];
#pragma unroll
                for (int n = 0; n < 2; ++n)
#pragma unroll
                    for (int j = 0; j < 4; ++j) { const float a = acc[ai][0][m][n][j], gg = acc[ai][1][m][n][j]; o[n * 4 + j] = silu_f(a) * gg; }
                u32x4 w; w.x = cvt_pk_bf16(o[0], o[1]); w.y = cvt_pk_bf16(o[2], o[3]); w.z = cvt_pk_bf16(o[4], o[5]); w.w = cvt_pk_bf16(o[6], o[7]);
                *(u32x4*)(O + (size_t)row * DFF + col0) = w;
            }
    }
};
struct EpiZ {
    static constexpr bool PERM = true, HAS_MID = false, AFTER_DRAIN = false;
    bf16_t* O; const float* rs;
    __device__ __forceinline__ void mid(f32x4 (&)[2][2][4][2], const Unit&, int, int, int, int) const {}
    __device__ __forceinline__ void operator()(const f32x4 (&acc)[2][2][4][2], const Unit& u, int wr, int wc, int fr, int fq) const {
        const int row0 = u.pm * BM + wr * 64 + fr, col0 = u.pn * BM + wc * 32 + 8 * fq;
        const int act = (u.pn < 4) ? 0 : ((u.pn >= 8 && u.pn < 12) ? 2 : 1);
#pragma unroll
        for (int ai = 0; ai < 2; ++ai)
#pragma unroll
            for (int m = 0; m < 4; ++m) {
                const int row = row0 + ai * HALF + m * 16;
#pragma unroll
                for (int bj = 0; bj < 2; ++bj) {
                    float o[8];
#pragma unroll
                    for (int n = 0; n < 2; ++n)
#pragma unroll
                        for (int j = 0; j < 4; ++j) { float v = acc[ai][bj][m][n][j]; if (act == 1) v = fast_sigmoid(v); else if (act == 2) v = gelu_tanh(v); o[n * 4 + j] = v; }
                    u32x4 w; w.x = cvt_pk_bf16(o[0], o[1]); w.y = cvt_pk_bf16(o[2], o[3]); w.z = cvt_pk_bf16(o[4], o[5]); w.w = cvt_pk_bf16(o[6], o[7]);
                    *(u32x4*)(O + (size_t)row * ZN + col0 + bj * HALF) = w;
                }
            }
    }
};
struct EpiZT {
    static constexpr bool PERM = true, HAS_MID = false, AFTER_DRAIN = false;
    bf16_t* O; const float* rs; float* SP;
    __device__ __forceinline__ void mid(f32x4 (&)[2][2][4][2], const Unit&, int, int, int, int) const {}
    __device__ __forceinline__ void operator()(const f32x4 (&acc)[2][2][4][2], const Unit& u, int wr, int wc, int fr, int fq) const {
        const int row0 = u.pm * BM + wr * 64 + fr, col0 = u.pn * BM + wc * 32 + 8 * fq;
        const bool gel = (u.pm >= 4);
        float cs[32];
#pragma unroll
        for (int i = 0; i < 32; ++i) cs[i] = 0.f;
#pragma unroll
        for (int ai = 0; ai < 2; ++ai)
#pragma unroll
            for (int m = 0; m < 4; ++m) {
                const int row = row0 + ai * HALF + m * 16;
#pragma unroll
                for (int bj = 0; bj < 2; ++bj) {
                    float o[8];
#pragma unroll
                    for (int n = 0; n < 2; ++n)
#pragma unroll
                        for (int j = 0; j < 4; ++j) { float v = acc[ai][bj][m][n][j]; if (gel) v = gelu_tanh(v); o[n * 4 + j] = v; }
                    u32x4 w; w.x = cvt_pk_bf16(o[0], o[1]); w.y = cvt_pk_bf16(o[2], o[3]); w.z = cvt_pk_bf16(o[4], o[5]); w.w = cvt_pk_bf16(o[6], o[7]);
                    *(u32x4*)(O + (size_t)row * NTOK + col0 + bj * HALF) = w;
                    if (gel) {
#pragma unroll
                        for (int e = 0; e < 8; ++e) { cs[bj * 8 + e] += o[e]; cs[16 + bj * 8 + e] += o[e] * o[e]; }
                    }
                }
            }
        if (gel) {
            float t8[16], t4[8], t2[4], t1[2];
            { const bool hi = (fr >> 3) & 1;
#pragma unroll
              for (int i = 0; i < 16; ++i) { const float keep = hi ? cs[16 + i] : cs[i], send = hi ? cs[i] : cs[16 + i]; t8[i] = keep + __shfl_xor(send, 8); } }
            { const bool hi = (fr >> 2) & 1;
#pragma unroll
              for (int i = 0; i < 8; ++i) { const float keep = hi ? t8[8 + i] : t8[i], send = hi ? t8[i] : t8[8 + i]; t4[i] = keep + __shfl_xor(send, 4); } }
            { const bool hi = (fr >> 1) & 1;
#pragma unroll
              for (int i = 0; i < 4; ++i) { const float keep = hi ? t4[4 + i] : t4[i], send = hi ? t4[i] : t4[4 + i]; t2[i] = keep + __shfl_xor(send, 2); } }
            { const bool hi = fr & 1;
#pragma unroll
              for (int i = 0; i < 2; ++i) { const float keep = hi ? t2[2 + i] : t2[i], send = hi ? t2[i] : t2[2 + i]; t1[i] = keep + __shfl_xor(send, 1); } }
            const int f7 = fr & 7, tok = u.pn * BM + (f7 >> 2) * HALF + wc * 32 + 8 * fq + 4 * ((f7 >> 1) & 1) + 2 * (f7 & 1);
            *(f32x2*)(SP + (size_t)((fr >> 3) * 8 + (u.pm - 4) * 2 + wr) * NTOK + tok) = (f32x2){t1[0], t1[1]};
        }
    }
};
template <int NV>
__device__ __forceinline__ void panel_exchange(LAS float* P, LAS float* S, unsigned* xbuf, unsigned* cnt, int pm, int pn, int tid, int wid, int lane) {
    asm volatile("s_waitcnt lgkmcnt(0)" ::: "memory"); __builtin_amdgcn_s_barrier(); asm volatile("" ::: "memory");
    if (tid < 256) {
        unsigned* slot = xbuf + ((size_t)(pm * 256 + tid) * 4 + pn) * NV;
#pragma unroll
        for (int v = 0; v < NV; ++v) { const float t = (P[(tid * 4 + 0) * NV + v] + P[(tid * 4 + 1) * NV + v]) + (P[(tid * 4 + 2) * NV + v] + P[(tid * 4 + 3) * NV + v]);
            __hip_atomic_store(slot + v, __float_as_uint(t), __ATOMIC_RELAXED, __HIP_MEMORY_SCOPE_AGENT); }
    }
    asm volatile("s_waitcnt vmcnt(0)" ::: "memory");
    if (lane == 0) __hip_atomic_fetch_add(cnt + 64 * pm, 1u, __ATOMIC_RELAXED, __HIP_MEMORY_SCOPE_AGENT);
    if (wid == 0) {
        unsigned spins = 0;
        while ((unsigned)__builtin_amdgcn_readfirstlane(__hip_atomic_load(cnt + 64 * pm, __ATOMIC_RELAXED, __HIP_MEMORY_SCOPE_AGENT)) < 32u) { __builtin_amdgcn_s_sleep(2); if (++spins > (1u << 22)) break; }
        __builtin_amdgcn_fence(__ATOMIC_ACQUIRE, "agent");
    }
    asm volatile("s_waitcnt vmcnt(0) lgkmcnt(0)" ::: "memory"); __builtin_amdgcn_s_barrier(); asm volatile("" ::: "memory");
    if (tid < 256) {
        const unsigned* slot = xbuf + (size_t)(pm * 256 + tid) * 4 * NV;
#pragma unroll
        for (int v = 0; v < NV; ++v) { float t = 0.f;
#pragma unroll
            for (int q = 0; q < 4; ++q) t += __uint_as_float(__hip_atomic_load(slot + q * NV + v, __ATOMIC_RELAXED, __HIP_MEMORY_SCOPE_AGENT));
            S[tid * NV + v] = t; }
    }
    asm volatile("s_waitcnt vmcnt(0) lgkmcnt(0)" ::: "memory"); __builtin_amdgcn_s_barrier(); asm volatile("" ::: "memory");
}
template <bool GATES> struct EpiRes {
    static constexpr bool PERM = false, HAS_MID = false, AFTER_DRAIN = true;
    static constexpr int NV2 = GATES ? 9 : 1;
    const float* Xin; float* X; int in_t, out_t; bf16_t* XB; float* RB; float* GB; const float* gain; float scale; const float* wg; const float* ibias; const float* fbias;
    unsigned* xch1; unsigned* xch2; unsigned* cnt1; unsigned* cnt2;
    __device__ __forceinline__ void mid(f32x4 (&)[2][2][4][2], const Unit&, int, int, int, int) const {}
    __device__ __forceinline__ void operator()(const f32x4 (&)[2][2][4][2], const Unit&, int, int, int, int) const {}
    __device__ __forceinline__ void fused(f32x4 (&acc)[2][2][4][2], const Unit& u, int wr, int wc, int fr, int fq, LAS unsigned char* lds, int tid, int wid, int lane) const {
        LAS float* P = (LAS float*)lds; LAS float* S = (LAS float*)(lds + 40960);
        const int rl0 = wr * 64 + fr, col0 = u.pn * BM + wc * 32 + 4 * fq;
#pragma unroll
        for (int ai = 0; ai < 2; ++ai)
#pragma unroll
            for (int m = 0; m < 4; ++m) { float q = 0.f;
#pragma unroll
                for (int bj = 0; bj < 2; ++bj)
#pragma unroll
                    for (int n = 0; n < 2; ++n) { const f32x4 d = acc[ai][bj][m][n]; q += (d[0] * d[0] + d[1] * d[1]) + (d[2] * d[2] + d[3] * d[3]); }
                q += __shfl_xor(q, 16); q += __shfl_xor(q, 32);
                if (fq == 0) P[(ai * HALF + rl0 + m * 16) * 4 + wc] = q; }
        f32x4 gv[2][2];
#pragma unroll
        for (int bj = 0; bj < 2; ++bj)
#pragma unroll
            for (int n = 0; n < 2; ++n) gv[bj][n] = *(const f32x4*)(gain + col0 + bj * HALF + n * 16);
        panel_exchange<1>(P, S, xch1, cnt1, u.pm, u.pn, tid, wid, lane);
        {
            const size_t rm0 = (size_t)(u.pm * BM + rl0) * DM + col0, tl0 = ((size_t)((u.pm * 4 + u.pn) * 8 + wid) * 32 * 64 + lane) * 4;
            const size_t ia0 = in_t ? tl0 : rm0, oa0 = out_t ? tl0 : rm0;
            const int isa = in_t ? 4096 : HALF * DM, ism = in_t ? 1024 : 16 * DM, isb = in_t ? 512 : HALF, isn = in_t ? 256 : 16;
            const int osa = out_t ? 4096 : HALF * DM, osm = out_t ? 1024 : 16 * DM, osb = out_t ? 512 : HALF, osn = out_t ? 256 : 16;
#pragma unroll
            for (int ai = 0; ai < 2; ++ai)
#pragma unroll
                for (int mh = 0; mh < 2; ++mh) {
                    f32x4 xv[2][2][2];
#pragma unroll
                    for (int mm = 0; mm < 2; ++mm) {
#pragma unroll
                        for (int bj = 0; bj < 2; ++bj)
#pragma unroll
                            for (int n = 0; n < 2; ++n) xv[mm][bj][n] = *(const f32x4*)(Xin + ia0 + (unsigned)(ai * isa + (mh * 2 + mm) * ism + bj * isb + n * isn)); }
#pragma unroll
                    for (int mm = 0; mm < 2; ++mm) { const int m = mh * 2 + mm, rl = ai * HALF + rl0 + m * 16; const float ry = scale * rsqrtf(S[rl] * (1.0f / DM) + EPS);
#pragma unroll
                        for (int bj = 0; bj < 2; ++bj)
#pragma unroll
                            for (int n = 0; n < 2; ++n) { const f32x4 xn = xv[mm][bj][n] + acc[ai][bj][m][n] * gv[bj][n] * ry;
                                acc[ai][bj][m][n] = xn; *(f32x4*)(X + oa0 + (unsigned)(ai * osa + m * osm + bj * osb + n * osn)) = xn; }
                        asm volatile("" : "+v"(acc[ai][0][m][0]), "+v"(acc[ai][0][m][1]), "+v"(acc[ai][1][m][0]), "+v"(acc[ai][1][m][1])); }
                    asm volatile("" ::: "memory"); }
        }
#pragma unroll
        for (int ai = 0; ai < 2; ++ai)
#pragma unroll
            for (int m = 0; m < 4; ++m) { float q = 0.f;
#pragma unroll
                for (int bj = 0; bj < 2; ++bj)
#pragma unroll
                    for (int n = 0; n < 2; ++n) { const f32x4 d = acc[ai][bj][m][n]; q += (d[0] * d[0] + d[1] * d[1]) + (d[2] * d[2] + d[3] * d[3]); }
                q += __shfl_xor(q, 16); q += __shfl_xor(q, 32);
                if (fq == 0) P[((ai * HALF + rl0 + m * 16) * 4 + wc) * NV2] = q; }
        if constexpr (GATES) {
#pragma unroll 2
            for (int j = 0; j < 8; ++j) {
                f32x4 wv[2][2];
#pragma unroll
                for (int bj = 0; bj < 2; ++bj)
#pragma unroll
                    for (int n = 0; n < 2; ++n) wv[bj][n] = *(const f32x4*)(wg + j * DM + col0 + bj * HALF + n * 16);
#pragma unroll
                for (int ai = 0; ai < 2; ++ai)
#pragma unroll
                    for (int m = 0; m < 4; ++m) { float q = 0.f;
#pragma unroll
                        for (int bj = 0; bj < 2; ++bj)
#pragma unroll
                            for (int n = 0; n < 2; ++n) { const f32x4 d = acc[ai][bj][m][n], w = wv[bj][n]; q += (d[0] * w[0] + d[1] * w[1]) + (d[2] * w[2] + d[3] * w[3]); }
                        q += __shfl_xor(q, 16); q += __shfl_xor(q, 32);
                        if (fq == 0) P[((ai * HALF + rl0 + m * 16) * 4 + wc) * NV2 + 1 + j] = q; }
            }
        }
        panel_exchange<NV2>(P, S, xch2, cnt2, u.pm, u.pn, tid, wid, lane);
#pragma unroll
        for (int ai = 0; ai < 2; ++ai)
#pragma unroll
            for (int m = 0; m < 4; ++m) { const int rl = ai * HALF + rl0 + m * 16; const float r = rsqrtf(S[rl * NV2] * (1.0f / DM) + EPS);
                const bool odd = (fq & 1) != 0;
                const size_t off = (size_t)(u.pm * BM + rl) * DM + u.pn * BM + wc * 32 + (odd ? 16 + 4 * (fq - 1) : 4 * fq);
#pragma unroll
                for (int bj = 0; bj < 2; ++bj) { const f32x4 x0 = acc[ai][bj][m][0] * r, x1 = acc[ai][bj][m][1] * r;
                    const unsigned p0x = cvt_pk_bf16(x0[0], x0[1]), p0y = cvt_pk_bf16(x0[2], x0[3]), p1x = cvt_pk_bf16(x1[0], x1[1]), p1y = cvt_pk_bf16(x1[2], x1[3]);
                    const unsigned rx = (unsigned)__shfl_xor((int)(odd ? p0x : p1x), 16), ry = (unsigned)__shfl_xor((int)(odd ? p0y : p1y), 16);
                    u32x4 w; w.x = odd ? rx : p0x; w.y = odd ? ry : p0y; w.z = odd ? p1x : rx; w.w = odd ? p1y : ry;
                    *(u32x4*)(XB + off + bj * HALF) = w; } }
        if (GATES && u.pn == 0 && tid < 256) {
            const int row = u.pm * BM + tid; const float r = rsqrtf(S[tid * NV2] * (1.0f / DM) + EPS);
            if constexpr (GATES) {
#pragma unroll
                for (int j = 0; j < 8; ++j) { float v = S[tid * NV2 + 1 + j] * r;
                    if (j < 4) v += ibias[j]; else { v += fbias[j - 4]; v = fminf(v, 0.f) - log1pf(expf(-fabsf(v))); }
                    GB[(size_t)row * 8 + j] = v; }
            }
        }
    }
};
struct EpiMerge {
    static constexpr bool PERM = true, HAS_MID = true, AFTER_DRAIN = false;
    bf16_t* O; const bf16_t* zn;
    __device__ __forceinline__ void mid(f32x4 (&acc)[2][2][4][2], const Unit& u, int wr, int wc, int fr, int fq) const {
        unsigned off0 = (unsigned)((u.pm * BM + wr * 64 + fr) * ZN + u.pn * BM + wc * 32 + 8 * fq) * 2u;
        asm volatile("" : "+v"(off0));
#pragma unroll
        for (int ai = 0; ai < 2; ++ai) {
            u32x4 sa[4][2], sb[4][2];
#pragma unroll
            for (int m = 0; m < 4; ++m) { const bf16_t* zr = (const bf16_t*)((const char*)zn + off0 + (unsigned)((ai * HALF + m * 16) * ZN * 2));
#pragma unroll
                for (int bj = 0; bj < 2; ++bj) { sa[m][bj] = *(const u32x4*)(zr + 3072 + bj * HALF); sb[m][bj] = *(const u32x4*)(zr + 4096 + bj * HALF); } }
#pragma unroll
            for (int m = 0; m < 4; ++m)
#pragma unroll
                for (int bj = 0; bj < 2; ++bj) {
                    const unsigned saw[4] = {sa[m][bj].x, sa[m][bj].y, sa[m][bj].z, sa[m][bj].w}, sbw[4] = {sb[m][bj].x, sb[m][bj].y, sb[m][bj].z, sb[m][bj].w};
#pragma unroll
                    for (int n = 0; n < 2; ++n)
#pragma unroll
                        for (int j = 0; j < 4; ++j) {
                            const int e = n * 4 + j; const unsigned wa = saw[e >> 1], wb = sbw[e >> 1];
                            const float a = (e & 1) ? bfhi(wa) : bflo(wa), b = (e & 1) ? bfhi(wb) : bflo(wb);
                            acc[ai][bj][m][n][j] *= a * __builtin_amdgcn_rcpf(b);
                        }
                }
            asm volatile("" ::: "memory");
        }
    }
    __device__ __forceinline__ void operator()(const f32x4 (&acc)[2][2][4][2], const Unit& u, int wr, int wc, int fr, int fq) const {
        const int row0 = u.pm * BM + wr * 64 + fr, col0 = u.pn * BM + wc * 32 + 8 * fq;
#pragma unroll
        for (int ai = 0; ai < 2; ++ai) {
            u32x4 sb[4][2];
#pragma unroll
            for (int m = 0; m < 4; ++m)
#pragma unroll
                for (int bj = 0; bj < 2; ++bj) sb[m][bj] = *(const u32x4*)(zn + (size_t)(row0 + ai * HALF + m * 16) * ZN + col0 + 4096 + bj * HALF);
#pragma unroll
            for (int m = 0; m < 4; ++m) {
                const int row = row0 + ai * HALF + m * 16;
#pragma unroll
                for (int bj = 0; bj < 2; ++bj) {
                    const unsigned sbw[4] = {sb[m][bj].x, sb[m][bj].y, sb[m][bj].z, sb[m][bj].w};
                    float o[8];
#pragma unroll
                    for (int n = 0; n < 2; ++n)
#pragma unroll
                        for (int j = 0; j < 4; ++j) { const int e = n * 4 + j; const unsigned wb = sbw[e >> 1]; o[e] = acc[ai][bj][m][n][j] * ((e & 1) ? bfhi(wb) : bflo(wb)); }
                    u32x4 w; w.x = cvt_pk_bf16(o[0], o[1]); w.y = cvt_pk_bf16(o[2], o[3]); w.z = cvt_pk_bf16(o[4], o[5]); w.w = cvt_pk_bf16(o[6], o[7]);
                    *(u32x4*)(O + (size_t)row * DM + col0 + bj * HALF) = w;
                }
            }
        }
    }
};
}

__device__ __forceinline__ void conv_item(const float* W, int ldw, int src_col0, int k0, const float* gain, bf16_t* dst, int dst_ld, int dst_row0, int dst_k0, float* scr, int lane) {
    asm volatile("" : "+v"(W), "+v"(dst));
    const int lr = lane >> 3, lc = (lane & 7) * 4;
    f32x4 v[8]; float gk[8];
#pragma unroll
    for (int i = 0; i < 8; ++i) { const int kk = 8 * i + lr; v[i] = *(const f32x4*)(W + (unsigned)((k0 + kk) * ldw + src_col0 + lc)); gk[i] = gain ? gain[k0 + kk] : 1.0f; }
#pragma unroll
    for (int i = 0; i < 8; ++i) { const int kk = 8 * i + lr; float* d = scr + kk * 33 + lc; d[0] = v[i][0] * gk[i]; d[1] = v[i][1] * gk[i]; d[2] = v[i][2] * gk[i]; d[3] = v[i][3] * gk[i]; }
    LDS_WAIT();
    const int c = lane & 7;
#pragma unroll
    for (int j = 0; j < 4; ++j) { const int n = (lane >> 3) + 8 * j; const float* s = scr + (8 * c) * 33 + n;
        u32x4 o; o.x = cvt_pk_bf16(s[0 * 33], s[1 * 33]); o.y = cvt_pk_bf16(s[2 * 33], s[3 * 33]); o.z = cvt_pk_bf16(s[4 * 33], s[5 * 33]); o.w = cvt_pk_bf16(s[6 * 33], s[7 * 33]);
        *(u32x4*)(dst + (unsigned)((dst_row0 + n) * dst_ld + dst_k0 + k0 + 8 * c)) = o; }
    LDS_WAIT();
}

__device__ __forceinline__ void convert_layer(const Params& pp, int lA, int lB, unsigned char* lds, int gw, int NGW, int lane, int wave) {
    Params p;
#define LND(a) { const float* t = pp.in[a]; asm volatile("" : "+s"(t)); p.in[a] = t; }
    LND(1) LND(2) LND(3) LND(4) LND(14) LND(15) LND(16) LND(17) LND(18)
#undef LND
    { unsigned char* t = pp.ws; asm volatile("" : "+s"(t)); p.ws = t; }
    float* scr = (float*)(lds + wave * 8448);
    unsigned char* ws = p.ws;
    constexpr int I_F1 = 16 * 176, I_F2 = 44 * 32, I_WN = 16 * 160, I_WT = 16 * 64, I_P = 16 * 32;
    constexpr int NA = I_F1 + I_F2 + I_WN + I_WT, NB = I_F1 + I_F2 + 3 * I_P;
    const int it_lo = (lA >= 0) ? 0 : NA, it_hi = (lB >= 0) ? NA + NB : NA;
    for (int it = it_lo + gw; it < it_hi; it += NGW) {
        const bool f = it >= NA; int r = f ? it - NA : it; const int l = f ? lB : lA;
        const float* gains = p.in[1] + (size_t)l * 6 * DM; asm volatile("" : "+v"(gains));
        if (r < I_F1) {
            const int kb = r / 176, nb = r % 176, j = nb * 32;
            const int src = ((j >> 7) & 1) * DFF + (j >> 8) * 128 + (j & 127);
            conv_item((f ? p.in[17] : p.in[2]) + (size_t)l * DM * 2 * DFF, 2 * DFF, src, kb * 64, gains + (f ? 4 : 0) * DM, (bf16_t*)(ws + (f ? WS_W1B : WS_W1A)), DM, j, 0, scr, lane);
            continue;
        }
        r -= I_F1;
        if (r < I_F2) {
            const int kb = r / 32, nb = r % 32;
            conv_item((f ? p.in[18] : p.in[3]) + (size_t)l * DFF * DM, DM, nb * 32, kb * 64, nullptr, (bf16_t*)(ws + (f ? WS_W2B : WS_W2A)), DFF, nb * 32, 0, scr, lane);
            continue;
        }
        r -= I_F2;
        if (!f) {
            const float* win = p.in[4] + (size_t)l * DM * WIN_COLS;
            if (r < I_WN) {
                const int kb = r / 160, nb = r % 160, j = nb * 32;
                const int src = (j < 1024) ? j : ((j < 3072) ? (j - 1024 + 2056) : (j - 3072 + 5128));
                conv_item(win, WIN_COLS, src, kb * 64, gains + 2 * DM, (bf16_t*)(ws + WS_WIN), DM, j, 0, scr, lane);
                continue;
            }
            r -= I_WN;
            {
                const int kb = r / 64, nb = r % 64, j = nb * 32;
                const int src = (j < 1024) ? (1024 + j) : (4104 + (j - 1024));
                conv_item(win, WIN_COLS, src, kb * 64, gains + 2 * DM, (bf16_t*)(ws + WS_WVT), DM, j, 0, scr, lane);
            }
        } else {
            const int which = r / I_P; r -= which * I_P; const int kb = r / 32, nb = r % 32;
            const float* src = (which == 0 ? p.in[14] : (which == 1 ? p.in[15] : p.in[16])) + (size_t)l * DM * DM;
            if (which < 2) conv_item(src, DM, nb * 32, kb * 64, nullptr, (bf16_t*)(ws + WS_WP), 2 * DM, nb * 32, which * DM, scr, lane);
            else conv_item(src, DM, nb * 32, kb * 64, nullptr, (bf16_t*)(ws + WS_WO), DM, nb * 32, 0, scr, lane);
        }
    }
    if (lA >= 0) {
        const float* gains = p.in[1] + (size_t)lA * 6 * DM; const float* win = p.in[4] + (size_t)lA * DM * WIN_COLS; float* wg = (float*)(ws + WS_WG); asm volatile("" : "+v"(win), "+v"(wg), "+v"(gains));
        for (int id = gw * 64 + lane; id < 8 * DM; id += NGW * 64) { const int j = id >> 10, k = id & 1023; wg[id] = gains[2 * DM + k] * win[(size_t)k * WIN_COLS + 2048 + j]; }
    }
}

template <int MODE, bool GATES>
__device__ __forceinline__ void ew_phase(const Params& p, int l, const float* src, const float* gain, float scale, int gw, int NGW, int lane) {
    float* X = p.out; bf16_t* XB = (bf16_t*)(p.ws + WS_XB); float* RB = (float*)(p.ws + WS_RB); float* GB = (float*)(p.ws + WS_GB);
    const float* wg = (const float*)(p.ws + WS_WG);
    asm volatile("" : "+v"(X), "+v"(XB), "+v"(src), "+v"(wg));
    for (int row = gw; row < NTOK; row += NGW) {
        f32x4 xv[4];
        if (MODE == 0) {
#pragma unroll
            for (int j = 0; j < 4; ++j) xv[j] = *(const f32x4*)(src + (size_t)row * DM + 256 * j + 4 * lane);
        } else {
            f32x4 yv[4]; float ss = 0.f;
#pragma unroll
            for (int j = 0; j < 4; ++j) { yv[j] = *(const f32x4*)(src + (size_t)row * DM + 256 * j + 4 * lane); xv[j] = *(const f32x4*)(X + (size_t)row * DM + 256 * j + 4 * lane);
                ss += (yv[j][0] * yv[j][0] + yv[j][1] * yv[j][1]) + (yv[j][2] * yv[j][2] + yv[j][3] * yv[j][3]); }
            const float ry = scale * rsqrtf(wave_sum(ss) * (1.0f / DM) + EPS);
#pragma unroll
            for (int j = 0; j < 4; ++j) { const f32x4 gv = *(const f32x4*)(gain + 256 * j + 4 * lane); xv[j] += yv[j] * gv * ry; }
        }
        float sx = 0.f;
#pragma unroll
        for (int j = 0; j < 4; ++j) {
            sx += (xv[j][0] * xv[j][0] + xv[j][1] * xv[j][1]) + (xv[j][2] * xv[j][2] + xv[j][3] * xv[j][3]);
        }
        const float r = rsqrtf(wave_sum(sx) * (1.0f / DM) + EPS);
#pragma unroll
        for (int j = 0; j < 4; ++j) { u32x2 w; w.x = cvt_pk_bf16(xv[j][0] * r, xv[j][1] * r); w.y = cvt_pk_bf16(xv[j][2] * r, xv[j][3] * r);
            *(u32x2*)(XB + (size_t)row * DM + 256 * j + 4 * lane) = w; }
        if (GATES) {
            float mine = 0.f;
#pragma unroll
            for (int g8 = 0; g8 < 8; ++g8) {
                float d = 0.f;
#pragma unroll
                for (int j = 0; j < 4; ++j) { const f32x4 wv = *(const f32x4*)(wg + g8 * DM + 256 * j + 4 * lane); d += (xv[j][0] * wv[0] + xv[j][1] * wv[1]) + (xv[j][2] * wv[2] + xv[j][3] * wv[3]); }
                d = wave_sum(d);
                if (lane == g8) mine = d;
            }
            if (lane < 8) {
                float v = mine * r;
                if (lane < 4) v += p.in[7][l * 4 + lane];
                else { v += p.in[8][l * 4 + (lane - 4)]; v = fminf(v, 0.f) - log1pf(expf(-fabsf(v))); }
                GB[(size_t)row * 8 + lane] = v;
            }
        }
    }
}

__device__ __forceinline__ u32x4 t21_pair(u32x2 a, u32x2 b, bool odd) {
    const unsigned rx = (unsigned)__shfl_xor((int)(odd ? a.x : b.x), 16), ry = (unsigned)__shfl_xor((int)(odd ? a.y : b.y), 16);
    u32x4 w; w.x = odd ? rx : a.x; w.y = odd ? ry : a.y; w.z = odd ? b.x : rx; w.w = odd ? b.y : ry; return w;
}
constexpr int PB = 272;
__device__ __forceinline__ bf16x8 ldfrag(const unsigned char* base, int row0, int ks, int lane) { return *(const bf16x8*)(base + (row0 + (lane & 15)) * PB + ks * 64 + (lane >> 4) * 16); }
__device__ __forceinline__ float scan_sum(float v, int lane) {
#pragma unroll
    for (int o = 1; o < 64; o <<= 1) { const float t = __shfl_up(v, o); if (lane >= o) v += t; }
    return v;
}
__device__ __forceinline__ float scan_max(float v, int lane) {
#pragma unroll
    for (int o = 1; o < 64; o <<= 1) { const float t = __shfl_up(v, o); if (lane >= o) v = fmaxf(v, t); }
    return v;
}
__device__ __forceinline__ void conv8(const u32x4 (&r)[5], int first, const float (&cw)[4][8], const float (&cb)[8], float (&o)[8]) {
#pragma unroll
    for (int e = 0; e < 8; ++e) {
        float a = cb[e];
#pragma unroll
        for (int j = 0; j < 4; ++j) { const u32x4 w = r[first + j]; const unsigned ww = (e >> 1) == 0 ? w.x : ((e >> 1) == 1 ? w.y : ((e >> 1) == 2 ? w.z : w.w)); a += cw[j][e] * ((e & 1) ? bfhi(ww) : bflo(ww)); }
        o[e] = silu_f(a);
    }
}

__device__ __forceinline__ void load_vt(unsigned char* dstl, const bf16_t* ZT, int zt_row0, int tok0, int tid) {
#pragma unroll
    for (int i = 0; i < 8; ++i) { const int q = tid + 512 * i, v = q >> 4, ch = q & 15;
        *(u32x4*)(dstl + v * PB + ch * 16) = *(const u32x4*)(ZT + (size_t)(zt_row0 + v) * NTOK + tok0 + ch * 8); }
    if (tid < 256) { const int v = 256 + (tid >> 4), ch = tid & 15; const unsigned f = (v == 256) ? 0x3F803F80u : 0u; *(u32x4*)(dstl + v * PB + ch * 16) = (u32x4){f, f, f, f}; }
}

__device__ __forceinline__ void ml1_job(const Params& p, int l, int job, unsigned char* lds, int tid, int lane, int wave) {
    const int b = job >> 7, h = (job >> 5) & 3, c = job & 31, tok0 = b * SEQ + c * 128;
    const bf16_t* zn = (const bf16_t*)(p.ws + WS_ZN); const bf16_t* ZT = (const bf16_t*)(p.ws + WS_ZT);
    const float* GB = (const float*)(p.ws + WS_GB); float* JS = (float*)(p.ws + WS_JS); bf16_t* DC = (bf16_t*)(p.ws + WS_DC);
    unsigned char* VT = lds; unsigned char* KT = lds + 272 * PB; float* wsm = (float*)(lds + 272 * PB + 128 * PB);
    load_vt(VT, ZT, h * 256, tok0, tid);
    const float* cwp = p.in[5] + (size_t)l * 4 * 1024; const float* cbp = p.in[6] + (size_t)l * 1024;
    float cw[2][4][8], cb[2][8]; u32x4 rk[2][5];
#pragma unroll
    for (int it = 0; it < 2; ++it) {
        const int d0 = (wave * 2 + it) * 8, chn = 512 + h * 128 + d0, s = 2 * lane;
#pragma unroll
        for (int e = 0; e < 8; ++e) { cb[it][e] = cbp[chn + e];
#pragma unroll
            for (int j = 0; j < 4; ++j) cw[it][j][e] = cwp[j * 1024 + chn + e]; }
#pragma unroll
        for (int i = 0; i < 5; ++i) { const int pos = c * 128 + s - 3 + i; rk[it][i] = (pos >= 0) ? *(const u32x4*)(zn + (size_t)(b * SEQ + pos) * ZN + chn) : (u32x4){0u, 0u, 0u, 0u}; }
    }
    if (wave == 0) {
        const float* g0p = GB + (size_t)(tok0 + 2 * lane) * 8;
        const float i0 = g0p[h], i1 = g0p[8 + h], f0 = g0p[4 + h], f1 = g0p[12 + h];
        const float incl = scan_sum(f0 + f1, lane), b1 = incl, b0 = incl - f1, bL = __shfl(incl, 63);
        const float g0 = bL - b0 + i0, g1 = bL - b1 + i1, mloc = wave_max(fmaxf(g0, g1));
        wsm[2 * lane] = __expf(g0 - mloc); wsm[2 * lane + 1] = __expf(g1 - mloc);
        if (lane == 0) { JS[job * 2] = mloc; JS[job * 2 + 1] = bL; }
    }
    __syncthreads();
#pragma unroll
    for (int it = 0; it < 2; ++it) {
        const int d0 = (wave * 2 + it) * 8, s = 2 * lane;
        float k0[8], k1[8]; conv8(rk[it], 0, cw[it], cb[it], k0); conv8(rk[it], 1, cw[it], cb[it], k1);
        const float w0 = wsm[s], w1 = wsm[s + 1];
#pragma unroll
        for (int e = 0; e < 8; ++e) *(unsigned*)(KT + (d0 + e) * PB + lane * 4) = cvt_pk_bf16(k0[e] * w0, k1[e] * w1);
    }
    __syncthreads();
    f32x4 acc[17];
#pragma unroll
    for (int i = 0; i < 17; ++i) acc[i] = (f32x4){0.f, 0.f, 0.f, 0.f};
#pragma unroll
    for (int ks = 0; ks < 4; ++ks) { const bf16x8 xk = ldfrag(KT, wave * 16, ks, lane);
#pragma unroll
        for (int mt = 0; mt < 17; ++mt) acc[mt] = __builtin_amdgcn_mfma_f32_16x16x32_bf16(xk, ldfrag(VT, mt * 16, ks, lane), acc[mt], 0, 0, 0); }
    bf16_t* o = DC + (size_t)job * DCJ + wave * 16 + 4 * (lane >> 4);
#pragma unroll
    for (int mp = 0; mp < 8; ++mp) { u32x2 a, b; a.x = cvt_pk_bf16(acc[2 * mp][0], acc[2 * mp][1]); a.y = cvt_pk_bf16(acc[2 * mp][2], acc[2 * mp][3]); b.x = cvt_pk_bf16(acc[2 * mp + 1][0], acc[2 * mp + 1][1]); b.y = cvt_pk_bf16(acc[2 * mp + 1][2], acc[2 * mp + 1][3]);
        const bool odd = ((lane >> 4) & 1) != 0;
        *(u32x4*)(o + ((2 * mp + (odd ? 1 : 0)) * 16 + (lane & 15)) * 128 - (odd ? 4 : 0)) = t21_pair(a, b, odd); }
    if ((lane & 15) == 0) { u32x2 w; w.x = cvt_pk_bf16(acc[16][0], acc[16][1]); w.y = cvt_pk_bf16(acc[16][2], acc[16][3]); *(u32x2*)(o + 256 * 128) = w; }
    __syncthreads();
}

__device__ __forceinline__ void ml2_scan(const Params& p, int gtid, int gthreads) {
    bf16_t* DC = (bf16_t*)(p.ws + WS_DC); const float* JS = (const float*)(p.ws + WS_JS); float* MS = (float*)(p.ws + WS_JS) + 1024;
    constexpr int E8 = DCJ / 8;
    for (int item = gtid; item < 16 * E8; item += gthreads) {
        const int bh = item / E8, e8 = item - bh * E8;
        float m = 0.f; float C[8];
#pragma unroll
        for (int e = 0; e < 8; ++e) C[e] = 0.f;
#pragma unroll 1
        for (int half = 0; half < 2; ++half) {
            u32x4 dv[16];
#pragma unroll
            for (int i = 0; i < 16; ++i) dv[i] = *(const u32x4*)(DC + (size_t)(bh * 32 + half * 16 + i) * DCJ + e8 * 8);
#pragma unroll
            for (int i = 0; i < 16; ++i) {
                const int job = bh * 32 + half * 16 + i; bf16_t* a = DC + (size_t)job * DCJ + e8 * 8;
                { u32x4 w; w.x = cvt_pk_bf16(C[0], C[1]); w.y = cvt_pk_bf16(C[2], C[3]); w.z = cvt_pk_bf16(C[4], C[5]); w.w = cvt_pk_bf16(C[6], C[7]); *(u32x4*)a = w; }
                const float mloc = JS[job * 2], bL = JS[job * 2 + 1];
                if (e8 == 0) MS[job] = m;
                const float mn = fmaxf(bL + m, mloc), al = __expf(bL + m - mn), be = __expf(mloc - mn);
                const unsigned dw[4] = {dv[i].x, dv[i].y, dv[i].z, dv[i].w};
#pragma unroll
                for (int e = 0; e < 4; ++e) { C[2 * e] = C[2 * e] * al + bflo(dw[e]) * be; C[2 * e + 1] = C[2 * e + 1] * al + bfhi(dw[e]) * be; }
                m = mn;
            }
        }
    }
}

__device__ __forceinline__ void ml3_job(const Params& p, int l, int job, unsigned char* lds, int tid, int lane, int wave) {
    const int b = job >> 7, h = (job >> 5) & 3, c = job & 31, tok0 = b * SEQ + c * 128;
    const bf16_t* zn = (const bf16_t*)(p.ws + WS_ZN); const bf16_t* ZT = (const bf16_t*)(p.ws + WS_ZT);
    const float* GB = (const float*)(p.ws + WS_GB); const float* MS = (const float*)(p.ws + WS_JS) + 1024; const bf16_t* DC = (const bf16_t*)(p.ws + WS_DC);
    bf16_t* hcat = (bf16_t*)(p.ws + WS_Y);
    unsigned char* Q = lds; unsigned char* KW = lds + 128 * PB; unsigned char* VC = lds + 256 * PB;
    float* aS = (float*)(lds + 528 * PB); float* Mx = aS + 128; float* bS = aS + 256;
    const float mc = MS[job];
    if (wave == 0) {
        const float* g0p = GB + (size_t)(tok0 + 2 * lane) * 8;
        const float i0 = g0p[h], i1 = g0p[8 + h], f0 = g0p[4 + h], f1 = g0p[12 + h];
        const float incl = scan_sum(f0 + f1, lane), b1 = incl, b0 = incl - f1;
        const float a0 = i0 - b0, a1 = i1 - b1;
        const float pin = scan_max(fmaxf(a0, a1), lane); float pex = __shfl_up(pin, 1); if (lane == 0) pex = -3.0e38f;
        const float p0 = fmaxf(pex, a0), p1 = pin;
        aS[2 * lane] = a0; aS[2 * lane + 1] = a1; bS[2 * lane] = b0; bS[2 * lane + 1] = b1;
        Mx[2 * lane] = fmaxf(mc, p0); Mx[2 * lane + 1] = fmaxf(mc, p1);
    }
    u32x4 cv[9];
    { const bf16_t* cs = DC + (size_t)job * DCJ;
#pragma unroll
      for (int i = 0; i < 9; ++i) { const int q = tid + 512 * i, v = q >> 4, ch = q & 15; cv[i] = (v < 257) ? *(const u32x4*)(cs + v * 128 + ch * 8) : (u32x4){0u, 0u, 0u, 0u}; } }
    const float* cwp = p.in[5] + (size_t)l * 4 * 1024; const float* cbp = p.in[6] + (size_t)l * 1024;
#pragma unroll 1
    for (int qk = 0; qk < 2; ++qk) {
        const int dch = tid & 15, tb = tid >> 4, chn = qk * 512 + h * 128 + dch * 8;
        float cw[4][8], cb[8];
#pragma unroll
        for (int e = 0; e < 8; e += 4) { const f32x4 b4 = *(const f32x4*)(cbp + chn + e); cb[e] = b4[0]; cb[e + 1] = b4[1]; cb[e + 2] = b4[2]; cb[e + 3] = b4[3];
#pragma unroll
            for (int j = 0; j < 4; ++j) { const f32x4 w4 = *(const f32x4*)(cwp + j * 1024 + chn + e); cw[j][e] = w4[0]; cw[j][e + 1] = w4[1]; cw[j][e + 2] = w4[2]; cw[j][e + 3] = w4[3]; } }
        u32x4 rr[4][4];
#pragma unroll
        for (int i = 0; i < 4; ++i)
#pragma unroll
            for (int j = 0; j < 4; ++j) { const int sp = c * 128 + tb + 32 * i - 3 + j; rr[i][j] = (sp >= 0) ? *(const u32x4*)(zn + (size_t)(b * SEQ + sp) * ZN + chn) : (u32x4){0u, 0u, 0u, 0u}; }
        const float sc = qk ? 1.0f : 0.08838834764831845f;
#pragma unroll
        for (int i = 0; i < 4; ++i) {
            const u32x4 r5[5] = {rr[i][0], rr[i][1], rr[i][2], rr[i][3], rr[i][3]};
            float o[8]; conv8(r5, 0, cw, cb, o);
            u32x4 w; w.x = cvt_pk_bf16(o[0] * sc, o[1] * sc); w.y = cvt_pk_bf16(o[2] * sc, o[3] * sc); w.z = cvt_pk_bf16(o[4] * sc, o[5] * sc); w.w = cvt_pk_bf16(o[6] * sc, o[7] * sc);
            *(u32x4*)((qk ? KW : Q) + (tb + 32 * i) * PB + dch * 16) = w;
        }
    }
#pragma unroll
    for (int i = 0; i < 9; ++i) { const int q = tid + 512 * i, v = q >> 4, ch = q & 15; if (v < 272) *(u32x4*)(VC + v * PB + ch * 16) = cv[i]; }
    __syncthreads();
    const int t0 = wave * 16, tl = t0 + (lane & 15), fq = lane >> 4;
    u32x4 vtr[8];
#pragma unroll
    for (int i = 0; i < 8; ++i) { const int q = tid + 512 * i, v = q >> 4, ch = q & 15; vtr[i] = *(const u32x4*)(ZT + (size_t)(h * 256 + v) * NTOK + tok0 + ch * 8); }
    bf16x8 qf[4];
#pragma unroll
    for (int ks = 0; ks < 4; ++ks) qf[ks] = ldfrag(Q, t0, ks, lane);
    f32x4 sacc[8];
#pragma unroll
    for (int st = 0; st < 8; ++st) { sacc[st] = (f32x4){0.f, 0.f, 0.f, 0.f};
        if (st <= wave) {
#pragma unroll
            for (int ks = 0; ks < 4; ++ks) sacc[st] = __builtin_amdgcn_mfma_f32_16x16x32_bf16(ldfrag(KW, st * 16, ks, lane), qf[ks], sacc[st], 0, 0, 0); } }
    f32x4 acc[17];
#pragma unroll
    for (int i = 0; i < 17; ++i) acc[i] = (f32x4){0.f, 0.f, 0.f, 0.f};
#pragma unroll
    for (int ks = 0; ks < 4; ++ks)
#pragma unroll
        for (int vt = 0; vt < 17; ++vt) acc[vt] = __builtin_amdgcn_mfma_f32_16x16x32_bf16(ldfrag(VC, vt * 16, ks, lane), qf[ks], acc[vt], 0, 0, 0);
    const float mxt = Mx[tl], bt = bS[tl];
#pragma unroll
    for (int st = 0; st < 8; ++st)
        if (st <= wave) {
            const f32x4 av = *(const f32x4*)(aS + st * 16 + 4 * fq);
#pragma unroll
            for (int r = 0; r < 4; ++r) { const int s = st * 16 + 4 * fq + r; sacc[st][r] = (s <= tl) ? __expf(av[r] - mxt) * sacc[st][r] : 0.f; }
        }
    __syncthreads();
#pragma unroll
    for (int st = 0; st < 8; ++st)
        if (st <= (wave | 1)) { u32x2 w; w.x = cvt_pk_bf16(sacc[st][0], sacc[st][1]); w.y = cvt_pk_bf16(sacc[st][2], sacc[st][3]); *(u32x2*)(KW + tl * PB + (st * 16 + 4 * fq) * 2) = w; }
#pragma unroll
    for (int i = 0; i < 8; ++i) { const int q = tid + 512 * i, v = q >> 4, ch = q & 15; *(u32x4*)(VC + v * PB + ch * 16) = vtr[i]; }
    if (tid < 256) { const int v = 256 + (tid >> 4), ch = tid & 15; const unsigned f = (v == 256) ? 0x3F803F80u : 0u; *(u32x4*)(VC + v * PB + ch * 16) = (u32x4){f, f, f, f}; }
    __syncthreads();
    const float sint = __expf(mc - mxt);
    const float* mg = p.in[9] + (size_t)l * 1024 + h * 256;
    const bf16_t* orow = zn + (size_t)(tok0 + tl) * ZN + 1024 + h * 256;
    f32x4 gva[16]; u32x2 owa[16];
#pragma unroll
    for (int vt = 0; vt < 16; ++vt) { const int v = vt * 16 + 4 * fq; gva[vt] = *(const f32x4*)(mg + v); owa[vt] = *(const u32x2*)(orow + v); }
#pragma unroll
    for (int vt = 0; vt < 17; ++vt) acc[vt] *= sint;
#pragma unroll
    for (int ks = 0; ks < 4; ++ks)
        if (ks <= (wave >> 1)) { const bf16x8 wf = ldfrag(KW, t0, ks, lane);
#pragma unroll
            for (int vt = 0; vt < 17; ++vt) acc[vt] = __builtin_amdgcn_mfma_f32_16x16x32_bf16(ldfrag(VC, vt * 16, ks, lane), wf, acc[vt], 0, 0, 0); }
    const float den = __shfl(acc[16][0], lane & 15);
    const float inv = 1.0f / fmaxf(fabsf(den), __expf(-(bt + mxt)));
    float s1 = 0.f;
#pragma unroll
    for (int vt = 0; vt < 16; ++vt) { acc[vt] *= inv; s1 += (acc[vt][0] + acc[vt][1]) + (acc[vt][2] + acc[vt][3]); }
    s1 += __shfl_xor(s1, 16); s1 += __shfl_xor(s1, 32);
    const float mu = s1 * (1.0f / 256.0f); float s2 = 0.f;
#pragma unroll
    for (int vt = 0; vt < 16; ++vt) { acc[vt] -= mu; s2 += (acc[vt][0] * acc[vt][0] + acc[vt][1] * acc[vt][1]) + (acc[vt][2] * acc[vt][2] + acc[vt][3] * acc[vt][3]); }
    s2 += __shfl_xor(s2, 16); s2 += __shfl_xor(s2, 32);
    const float rstd = rsqrtf(s2 * (1.0f / 256.0f) + EPS);
    bf16_t* hrow = hcat + (size_t)(tok0 + tl) * HC + h * 256;
#pragma unroll
    for (int vp = 0; vp < 8; ++vp) { u32x2 pc[2];
#pragma unroll
        for (int h2 = 0; h2 < 2; ++h2) { const int vt = 2 * vp + h2; const f32x4 gv = gva[vt]; const u32x2 ow = owa[vt];
            const float o0 = bflo(ow.x) * acc[vt][0] * rstd * gv[0], o1 = bfhi(ow.x) * acc[vt][1] * rstd * gv[1], o2 = bflo(ow.y) * acc[vt][2] * rstd * gv[2], o3 = bfhi(ow.y) * acc[vt][3] * rstd * gv[3];
            pc[h2].x = cvt_pk_bf16(o0, o1); pc[h2].y = cvt_pk_bf16(o2, o3); }
        const bool odd = (fq & 1) != 0;
        *(u32x4*)(hrow + 32 * vp + (odd ? 16 + 4 * (fq - 1) : 4 * fq)) = t21_pair(pc[0], pc[1], odd); }
    __syncthreads();
}

__device__ __forceinline__ void gmlp_job(const Params& p, int l, int job, unsigned char* lds, int tid, int lane, int wave) {
    const int g = job & 3, bc = job >> 2, tok0 = bc * 128;
    const bf16_t* zn = (const bf16_t*)(p.ws + WS_ZN); const bf16_t* ZT = (const bf16_t*)(p.ws + WS_ZT);
    bf16_t* hcat = (bf16_t*)(p.ws + WS_Y);
    unsigned char* WM = lds; unsigned char* VN = lds + 128 * PB;
    float* mu = (float*)(lds + 384 * PB); float* rs = mu + 128;
    u32x4 vw[8]; float gaa[8], bea[8];
    { const float* gam = p.in[10] + (size_t)l * 1024 + g * 256; const float* bet = p.in[11] + (size_t)l * 1024 + g * 256;
#pragma unroll
      for (int i = 0; i < 8; ++i) { const int q = tid + 512 * i, d = q >> 4, ch = q & 15; vw[i] = *(const u32x4*)(ZT + (size_t)(1024 + g * 256 + d) * NTOK + tok0 + ch * 8); gaa[i] = gam[d]; bea[i] = bet[d]; } }
    if (tid < 128) { const float* SP = (const float*)(p.ws + WS_SP) + tok0 + tid; float sm = 0.f, sq = 0.f;
#pragma unroll
        for (int i = 0; i < 8; ++i) { sm += SP[(size_t)i * NTOK]; sq += SP[(size_t)(8 + i) * NTOK]; }
        const float m = sm * (1.0f / 1024.0f), var = fmaxf(sq * (1.0f / 1024.0f) - m * m, 0.f);
        mu[tid] = m; rs[tid] = rsqrtf(var + EPS); }
    {
        const float* wsp = p.in[12] + ((size_t)l * 4 + g) * 128 * 128;
#pragma unroll
        for (int i = 0; i < 4; ++i) { const int q = tid + 512 * i, t = q >> 4, ch = q & 15; const f32x4 x0 = *(const f32x4*)(wsp + t * 128 + ch * 8), x1 = *(const f32x4*)(wsp + t * 128 + ch * 8 + 4);
            float o[8] = {x0[0], x0[1], x0[2], x0[3], x1[0], x1[1], x1[2], x1[3]};
#pragma unroll
            for (int e = 0; e < 8; ++e) if (ch * 8 + e > t) o[e] = 0.f;
            u32x4 w; w.x = cvt_pk_bf16(o[0], o[1]); w.y = cvt_pk_bf16(o[2], o[3]); w.z = cvt_pk_bf16(o[4], o[5]); w.w = cvt_pk_bf16(o[6], o[7]);
            *(u32x4*)(WM + t * PB + ch * 16) = w; }
    }
    __syncthreads();
    {
#pragma unroll
        for (int i = 0; i < 8; ++i) { const int q = tid + 512 * i, d = q >> 4, ch = q & 15;
            const u32x4 w = vw[i];
            const unsigned ww[4] = {w.x, w.y, w.z, w.w}; const float ga = gaa[i], be = bea[i];
            const f32x4 m0 = *(const f32x4*)(mu + ch * 8), m1 = *(const f32x4*)(mu + ch * 8 + 4), r0 = *(const f32x4*)(rs + ch * 8), r1 = *(const f32x4*)(rs + ch * 8 + 4);
            const float mm[8] = {m0[0], m0[1], m0[2], m0[3], m1[0], m1[1], m1[2], m1[3]}, rr[8] = {r0[0], r0[1], r0[2], r0[3], r1[0], r1[1], r1[2], r1[3]};
            float o[8];
#pragma unroll
            for (int e = 0; e < 4; ++e) { o[2 * e] = (bflo(ww[e]) - mm[2 * e]) * rr[2 * e] * ga + be; o[2 * e + 1] = (bfhi(ww[e]) - mm[2 * e + 1]) * rr[2 * e + 1] * ga + be; }
            u32x4 wo; wo.x = cvt_pk_bf16(o[0], o[1]); wo.y = cvt_pk_bf16(o[2], o[3]); wo.z = cvt_pk_bf16(o[4], o[5]); wo.w = cvt_pk_bf16(o[6], o[7]);
            *(u32x4*)(VN + d * PB + ch * 16) = wo; }
    }
    __syncthreads();
    const int t0 = wave * 16, tl = t0 + (lane & 15), fq = lane >> 4;
    const bf16_t* urow = zn + (size_t)(tok0 + tl) * ZN + 2048 + g * 256;
    u32x2 uwa[16];
#pragma unroll
    for (int dt = 0; dt < 16; ++dt) uwa[dt] = *(const u32x2*)(urow + dt * 16 + 4 * fq);
    f32x4 acc[16];
#pragma unroll
    for (int i = 0; i < 16; ++i) acc[i] = (f32x4){0.f, 0.f, 0.f, 0.f};
#pragma unroll
    for (int ks = 0; ks < 4; ++ks)
        if (ks <= (wave >> 1)) { const bf16x8 wf = ldfrag(WM, t0, ks, lane);
#pragma unroll
            for (int dt = 0; dt < 16; ++dt) acc[dt] = __builtin_amdgcn_mfma_f32_16x16x32_bf16(ldfrag(VN, dt * 16, ks, lane), wf, acc[dt], 0, 0, 0); }
    const float bs = p.in[13][((size_t)l * 4 + g) * 128 + tl];
    bf16_t* hrow = hcat + (size_t)(tok0 + tl) * HC + 1024 + g * 256;
#pragma unroll
    for (int dp = 0; dp < 8; ++dp) { u32x2 pc[2];
#pragma unroll
        for (int h2 = 0; h2 < 2; ++h2) { const int dt = 2 * dp + h2; const u32x2 uw = uwa[dt];
            pc[h2].x = cvt_pk_bf16(bflo(uw.x) * (acc[dt][0] + bs), bfhi(uw.x) * (acc[dt][1] + bs)); pc[h2].y = cvt_pk_bf16(bflo(uw.y) * (acc[dt][2] + bs), bfhi(uw.y) * (acc[dt][3] + bs)); }
        const bool odd = (fq & 1) != 0;
        *(u32x4*)(hrow + 32 * dp + (odd ? 16 + 4 * (fq - 1) : 4 * fq)) = t21_pair(pc[0], pc[1], odd); }
    __syncthreads();
}


#define RLX_AGENT __ATOMIC_RELAXED, __HIP_MEMORY_SCOPE_AGENT
#define XB_TMO      128
#define XB_XCNT(j)  (256  + 64 * (j))
#define XB_XSUB(j)  (1280 + 64 * (j))
#define XB_XGEN(j)  (2304 + 64 * (j))
#define XB_TOP      3328
#define XB_TOPGEN   3392
#define XCD_BAR_WORDS 3456
#define XB_SPIN_CAP (1u << 18)

__device__ __forceinline__ unsigned xb_ld(unsigned* p)              { return __hip_atomic_load(p, __ATOMIC_RELAXED, __HIP_MEMORY_SCOPE_AGENT); }
__device__ __forceinline__ unsigned xb_add(unsigned* p, unsigned v) { return __hip_atomic_fetch_add(p, v, __ATOMIC_RELAXED, __HIP_MEMORY_SCOPE_AGENT); }
__device__ __forceinline__ unsigned xb_xcc_id() { return (unsigned)__builtin_amdgcn_s_getreg((3 << 11) | 20) & 0xFu; }
#define XB_SPIN(cond, bar) do { unsigned _sp = 0; while (cond) { __builtin_amdgcn_s_sleep(1); \
    if ((++_sp & 255u) == 0u) { if (xb_ld(&(bar)[XB_TMO])) break; if (_sp > XB_SPIN_CAP) { atomicAdd(&(bar)[XB_TMO], 1u); break; } } } } while (0)

struct XcdBarrier {
    unsigned* bar; unsigned x;
    volatile LAS unsigned* st;
};

__device__ __forceinline__ XcdBarrier xcd_barrier_post(unsigned* bar, volatile LAS unsigned* st) {
    XcdBarrier b; b.bar = bar; b.x = xb_xcc_id(); b.st = st;
    if (threadIdx.x == 0) (void)xb_add(&bar[XB_XCNT(b.x)], 1u);
    return b;
}
__device__ __forceinline__ void xcd_barrier_complete(unsigned* bar, unsigned x, unsigned& nloc, unsigned& nx) {
    const unsigned G = gridDim.x * gridDim.y * gridDim.z;
    unsigned sum, cnt, mine, sp = 0u;
    for (;;) {
        sum = 0u; cnt = 0u; mine = 0u;
#pragma unroll
        for (unsigned j = 0; j < 16; ++j) { const unsigned c = xb_ld(&bar[XB_XCNT(j)]); sum += c; cnt += (c > 0u) ? 1u : 0u; mine = (j == x) ? c : mine; }
        if (sum == G) break;
        __builtin_amdgcn_s_sleep(1);
        if ((++sp & 255u) == 0u) { if (xb_ld(&bar[XB_TMO])) break; if (sp > XB_SPIN_CAP) { atomicAdd(&bar[XB_TMO], 1u); break; } }
    }
    nloc = mine > 0u ? mine : 1u; nx = cnt > 0u ? cnt : 1u;
}

__device__ __forceinline__ void xcd_barrier(const XcdBarrier& b) {
    asm volatile("s_waitcnt vmcnt(0)" ::: "memory");
    __syncthreads();
    if (threadIdx.x == 0) {
        unsigned* bar = b.bar;
        __builtin_amdgcn_s_waitcnt(0);
        unsigned nloc = b.st[0], nx = b.st[1];
        if (nloc == 0u) { xcd_barrier_complete(bar, b.x, nloc, nx); b.st[0] = nloc; b.st[1] = nx; }
        const unsigned old = xb_add(&bar[XB_XSUB(b.x)], 1u);
        const unsigned gen = old / nloc;
        if (old + 1u == (gen + 1u) * nloc) {
            __builtin_amdgcn_fence(__ATOMIC_RELEASE, "agent");
            asm volatile("s_waitcnt vmcnt(0)" ::: "memory");
            const unsigned og = xb_add(&bar[XB_TOP], 1u);
            const unsigned tg = og / nx;
            if (og + 1u == (tg + 1u) * nx) xb_add(&bar[XB_TOPGEN], 1u);
            else XB_SPIN(xb_ld(&bar[XB_TOPGEN]) == tg, bar);
            __builtin_amdgcn_fence(__ATOMIC_ACQUIRE, "agent");
            xb_add(&bar[XB_XGEN(b.x)], 1u);
            asm volatile("s_waitcnt vmcnt(0)" ::: "memory");
        } else {
            XB_SPIN(xb_ld(&bar[XB_XGEN(b.x)]) == gen, bar);
            __builtin_amdgcn_fence(__ATOMIC_ACQUIRE, "agent");
            asm volatile("s_waitcnt vmcnt(0)" ::: "memory");
        }
    }
    __syncthreads();
}


#define LAYER_IDS() int lo = l; asm volatile("" : "+s"(lo)); const float* gains = p.in[1] + (size_t)lo * 6 * DM
#define PHASE_IDS() int G = G0, bx = bx0; asm volatile("" : "+s"(G), "+s"(bx)); const int NGW = G * NWAVES; (void)NGW; unsigned zz_ = 0u; asm volatile("" : "+v"(zz_)); const int lane = (int)__builtin_amdgcn_mbcnt_hi(~0u, __builtin_amdgcn_mbcnt_lo(~0u, zz_)), wave = wave_s; const int tid = wave * 64 + lane; const int gw = bx * NWAVES + wave; (void)lane; (void)gw
__global__ void __launch_bounds__(NTHREADS, 2) fwd_megakernel(Params p) {
    extern __shared__ __attribute__((aligned(16))) unsigned char lds[];
    cg::grid_group grid = cg::this_grid();
    const int G0 = gridDim.x, bx0 = blockIdx.x;
    const int wave_s = __builtin_amdgcn_readfirstlane((int)threadIdx.x >> 6);
    if (threadIdx.x < 4) ((volatile LAS unsigned*)((LAS unsigned char*)lds + BAR_LDS_OFF))[threadIdx.x] = 0u;
    __syncthreads();
    const XcdBarrier xbar = xcd_barrier_post((unsigned*)(p.ws + WS_BAR), (volatile LAS unsigned*)((LAS unsigned char*)lds + BAR_LDS_OFF));
    LAS unsigned char* ldsl = (LAS unsigned char*)lds;
    unsigned char* ws = p.ws;
    const float* RB = (const float*)(ws + WS_RB);
    bf16_t* XB = (bf16_t*)(ws + WS_XB); bf16_t* ZNp = (bf16_t*)(ws + WS_ZN); bf16_t* ZTp = (bf16_t*)(ws + WS_ZT); float* Y = (float*)(ws + WS_Y);
    bf16_t* HID = ZNp; bf16_t* HCAT = (bf16_t*)(ws + WS_Y); bf16_t* MRG = XB;

    { PHASE_IDS(); ew_phase<0, false>(p, 0, p.in[0], nullptr, 0.f, gw, NGW, lane); convert_layer(p, 0, -1, lds, gw, NGW, lane, wave); }
    grid.sync();

    for (int l = 0; l < DEPTH; ++l) {
        for (int f = 0; f < 2; ++f) {
            if (bx0 >= G0 / 2) { PHASE_IDS(); LAYER_IDS(); (void)gains; const int hw = (bx - G / 2) * NWAVES + wave, HNW = (G - G / 2) * NWAVES;
              if (f == 0) convert_layer(p, -1, lo, lds, hw, HNW, lane, wave); else if (l + 1 < DEPTH) convert_layer(p, lo + 1, -1, lds, hw, HNW, lane, wave); }
            __syncthreads();
            { PHASE_IDS(); pg8::Gemm g{XB, (const bf16_t*)(ws + (f ? WS_W1B : WS_W1A)), NTOK, 2 * DFF, DM}; pg8::StaticOrder S; S.init(NTOK, 2 * DFF, G, bx);
              pg8::EpiSwiGLU E{HID, RB}; pg8::gemm_phase(ldsl, g, S, E, tid); }
            xcd_barrier(xbar);
            if (f == 0) { PHASE_IDS(); LAYER_IDS(); pg8::Gemm g{HID, (const bf16_t*)(ws + WS_W2A), NTOK, DM, DFF}; pg8::StaticOrder S; S.init(NTOK, DM, G, bx);
              pg8::EpiRes<true> E{(lo == 0) ? p.in[0] : (const float*)(ws + WS_XT), (float*)(ws + WS_XT), (lo == 0) ? 0 : 1, 1, XB, (float*)(ws + WS_RB), (float*)(ws + WS_GB), gains + 1 * DM, 0.5f, (const float*)(ws + WS_WG), p.in[7] + lo * 4, p.in[8] + lo * 4,
                                  (unsigned*)(ws + WS_XCH), (unsigned*)(ws + WS_XCH) + NTOK * 4, (unsigned*)(ws + WS_CNT) + (lo * 6 + 0) * 4096, (unsigned*)(ws + WS_CNT) + (lo * 6 + 1) * 4096};
              pg8::gemm_phase(ldsl, g, S, E, tid); }
            else { PHASE_IDS(); LAYER_IDS(); pg8::Gemm g{HID, (const bf16_t*)(ws + WS_W2B), NTOK, DM, DFF}; pg8::StaticOrder S; S.init(NTOK, DM, G, bx);
              pg8::EpiRes<false> E{(const float*)(ws + WS_XT), (l == DEPTH - 1) ? p.out : (float*)(ws + WS_XT), 1, (l == DEPTH - 1) ? 0 : 1, XB, (float*)(ws + WS_RB), nullptr, gains + 5 * DM, 0.5f, nullptr, nullptr, nullptr,
                                   (unsigned*)(ws + WS_XCH), (unsigned*)(ws + WS_XCH) + NTOK * 4, (unsigned*)(ws + WS_CNT) + (lo * 6 + 4) * 4096, (unsigned*)(ws + WS_CNT) + (lo * 6 + 5) * 4096};
              pg8::gemm_phase(ldsl, g, S, E, tid); }
            if (!(l == DEPTH - 1 && f == 1)) xcd_barrier(xbar);
            if (f == 0) {
                { PHASE_IDS(); pg8::Gemm g{XB, (const bf16_t*)(ws + WS_WIN), NTOK, ZN, DM}; pg8::StaticOrder S; S.init(NTOK, ZN, G, bx);
                  pg8::EpiZ E{ZNp, RB}; pg8::gemm_phase(ldsl, g, S, E, tid); }
                { PHASE_IDS(); pg8::Gemm g{(const bf16_t*)(ws + WS_WVT), XB, ZTR, NTOK, DM}; pg8::StaticOrder S; S.init(ZTR, NTOK, G, bx);
                  pg8::EpiZT E{ZTp, RB, (float*)(ws + WS_SP)}; pg8::gemm_phase(ldsl, g, S, E, tid); }
                xcd_barrier(xbar);
                for (int it = bx0; it < 1024; it += G0) { PHASE_IDS(); LAYER_IDS(); (void)gains; if (it < 512) ml1_job(p, lo, it, lds, tid, lane, wave); else gmlp_job(p, lo, it - 512, lds, tid, lane, wave); }
                xcd_barrier(xbar);
                { PHASE_IDS(); LAYER_IDS(); (void)gains; ml2_scan(p, bx * NTHREADS + tid, G * NTHREADS); }
                xcd_barrier(xbar);
                for (int it = bx0; it < 512; it += G0) { PHASE_IDS(); LAYER_IDS(); (void)gains; ml3_job(p, lo, it, lds, tid, lane, wave); }
                xcd_barrier(xbar);
                { PHASE_IDS(); pg8::Gemm g{HCAT, (const bf16_t*)(ws + WS_WP), NTOK, DM, 2 * DM}; pg8::StaticOrder S; S.init(NTOK, DM, G, bx);
                  pg8::EpiMerge E{MRG, ZNp}; pg8::gemm_phase(ldsl, g, S, E, tid); }
                xcd_barrier(xbar);
                { PHASE_IDS(); LAYER_IDS(); pg8::Gemm g{MRG, (const bf16_t*)(ws + WS_WO), NTOK, DM, DM}; pg8::StaticOrder S; S.init(NTOK, DM, G, bx);
                  pg8::EpiRes<false> E{(const float*)(ws + WS_XT), (float*)(ws + WS_XT), 1, 1, MRG, (float*)(ws + WS_RB), nullptr, gains + 3 * DM, 1.0f, nullptr, nullptr, nullptr,
                                       (unsigned*)(ws + WS_XCH), (unsigned*)(ws + WS_XCH) + NTOK * 4, (unsigned*)(ws + WS_CNT) + (lo * 6 + 2) * 4096, (unsigned*)(ws + WS_CNT) + (lo * 6 + 3) * 4096};
                  pg8::gemm_phase(ldsl, g, S, E, tid); }
                xcd_barrier(xbar);
            }
        }
    }
}

extern "C" void kernel_launch(void* const* d_in, const int* in_sizes, int n_in, void* d_out, int out_size, void* d_ws, size_t ws_size, hipStream_t stream) {
    static int grid_blocks = 0;
    if (!grid_blocks) {
        int dev = 0, cus = 0, per_cu = 0;
        hipGetDevice(&dev);
        hipDeviceGetAttribute(&cus, hipDeviceAttributeMultiprocessorCount, dev);
        hipFuncSetAttribute((const void*)fwd_megakernel, hipFuncAttributeMaxDynamicSharedMemorySize, LDS_BYTES);
        hipOccupancyMaxActiveBlocksPerMultiprocessor(&per_cu, (const void*)fwd_megakernel, NTHREADS, LDS_BYTES);
        if (per_cu < 1) per_cu = 1;
        grid_blocks = cus * 1;
        if (ws_size < WS_END) { fprintf(stderr, "kernel_launch: workspace too small (%zu < %zu)\n", ws_size, (size_t)WS_END); }
    }
    (void)hipMemsetAsync((char*)d_ws + WS_BAR, 0, 65536 + 24 * 4096 * 4, stream);
    Params p{};
    for (int i = 0; i < 19; ++i) p.in[i] = (const float*)d_in[i];
    p.out = (float*)d_out; p.ws = (unsigned char*)d_ws;
    void* args[] = {&p};
    hipError_t e = hipLaunchCooperativeKernel((const void*)fwd_megakernel, dim3(grid_blocks), dim3(NTHREADS), args, LDS_BYTES, stream);
    if (e != hipSuccess) fprintf(stderr, "cooperative launch failed: %s (grid %d)\n", hipGetErrorString(e), grid_blocks);
}
```
